# Optimizing an MI355X kernel written in HIP

```python
import math
import jax, jax.numpy as jnp
from jax import lax
import numpy as np

D_MODEL = 1024
BATCH = 16
SEQ = 256
DEPTH = 4
DEC_BATCH = 4
DEC_SEQ = 1024
PAST_LEN = 256

GRID_W = 64
N_MIXERS = 3
N_A = (DEPTH + 2) // 3
N_B = (DEPTH + 1) // 3
N_C = DEPTH // 3
H_A = 8
DH_A = D_MODEL // (2 * H_A)
DV_A = 2 * DH_A
E_A = H_A * DV_A
H_B = 4
DK_B = D_MODEL // H_B
DV_B = 2 * DK_B
E_B = H_B * DV_B
CHUNK = 128
E_C = D_MODEL
CONV_W = 3
ALPHA = (2.0 * DEPTH) ** 0.25
BETA = (8.0 * DEPTH) ** -0.25
ROPE_BASE = 10000.0
Q_BLOCK = 128
LN_EPS = 1e-5

kernel_name = "hybrid_diffusion_diffattn_retnet_shortconv_step"


def layer_norm(x, g, b):
    xf = x.astype(jnp.float32)
    mu = jnp.mean(xf, -1, keepdims=True)
    var = jnp.mean(jnp.square(xf - mu), -1, keepdims=True)
    return ((xf - mu) * lax.rsqrt(var + LN_EPS)).astype(x.dtype) * g + b


def rms_norm(x, eps=1e-6):
    xf = x.astype(jnp.float32)
    return (xf * lax.rsqrt(jnp.mean(jnp.square(xf), -1, keepdims=True) + eps)).astype(x.dtype)


def ada_modulation(cvec, w_mod, b_mod):
    m = jax.nn.silu(cvec) @ w_mod + b_mod
    shift, scale, gate = jnp.split(m[:, None, :], 3, axis=-1)
    return shift, scale, gate


def axial_rope(n_tokens, dim):
    rows = n_tokens // GRID_W
    r = jnp.repeat(jnp.arange(rows, dtype=jnp.float32), GRID_W)
    col = jnp.tile(jnp.arange(GRID_W, dtype=jnp.float32), rows)
    n_freq = dim // 4
    inv = ROPE_BASE ** (-jnp.arange(n_freq, dtype=jnp.float32) / n_freq)
    ang = jnp.concatenate([r[:, None] * inv, col[:, None] * inv], -1)
    return jnp.cos(ang), jnp.sin(ang)


def apply_rope(x, cos, sin):
    xf = x.astype(jnp.float32)
    x1, x2 = jnp.split(xf, 2, axis=-1)
    c = cos[None, :, None, None, :]
    s = sin[None, :, None, None, :]
    return jnp.concatenate([x1 * c - x2 * s, x1 * s + x2 * c], -1).astype(x.dtype)


def diff_lambda(lam, layer_idx):
    lam = lam.astype(jnp.float32)
    lam_init = 0.8 - 0.6 * math.exp(-0.3 * layer_idx)
    val = jnp.exp(jnp.sum(lam[0] * lam[1])) - jnp.exp(jnp.sum(lam[2] * lam[3])) + lam_init
    return val, lam_init


def diff_project(h, w_in):
    b, t, _ = h.shape
    q, k, v, z = jnp.split(h @ w_in, 4, axis=-1)
    return (q.reshape(b, t, H_A, 2, DH_A), k.reshape(b, t, H_A, 2, DH_A),
            v.reshape(b, t, H_A, DV_A), z)


def diff_attention(q, k, v, lam):
    b, t = q.shape[:2]
    nb = t // Q_BLOCK
    qb = jnp.moveaxis(q.reshape(b, nb, Q_BLOCK, H_A, 2, DH_A), 1, 0)
    scale = DH_A ** -0.5

    def block(qblk):
        s = jnp.einsum('bqhmd,bshmd->bhmqs', qblk, k).astype(jnp.float32) * scale
        p = jax.nn.softmax(s, axis=-1)
        a = p[:, :, 0] - lam * p[:, :, 1]
        return jnp.einsum('bhqs,bshd->bqhd', a.astype(v.dtype), v)

    o = lax.map(block, qb)
    return jnp.moveaxis(o, 0, 1).reshape(b, t, H_A, DV_A)


def diff_output(o, z, lam_init, subln_g, w_out):
    o = rms_norm(o) * subln_g * (1.0 - lam_init)
    o = o.reshape(o.shape[0], o.shape[1], E_A)
    return (o * jax.nn.silu(z)) @ w_out


def ret_project(h, w_in):
    b, t, _ = h.shape
    q, k, v, g = jnp.split(h @ w_in, [H_B * DK_B, 2 * H_B * DK_B, 2 * H_B * DK_B + E_B], axis=-1)
    q = q.reshape(b, t, H_B, DK_B)
    k = k.reshape(b, t, H_B, DK_B) * (DK_B ** -0.5)
    v = v.reshape(b, t, H_B, DV_B)
    return q, k, v, g


def log_decay(a):
    return jnp.log1p(-jnp.exp(a.astype(jnp.float32)))


def retention_chunkwise(q, k, v, lg, state0):
    b, t = q.shape[:2]
    nc = t // CHUNK

    def chunks(x):
        return jnp.moveaxis(x.reshape(b, nc, CHUNK, *x.shape[2:]), 1, 0)

    idx = jnp.arange(CHUNK, dtype=jnp.float32)
    diff = idx[:, None] - idx[None, :]
    dmask = jnp.where(diff[None] >= 0, jnp.exp(jnp.maximum(diff, 0.0)[None] * lg[:, None, None]), 0.0)
    q_decay = jnp.exp((idx[:, None] + 1.0) * lg[None, :])
    k_decay = jnp.exp((CHUNK - 1.0 - idx)[:, None] * lg[None, :])
    c_decay = jnp.exp(CHUNK * lg)

    def step(s, xs):
        qc, kc, vc = xs
        qf, kf, vf = qc.astype(jnp.float32), kc.astype(jnp.float32), vc.astype(jnp.float32)
        qk = jnp.einsum('bnhd,bmhd->bhnm', qf, kf) * dmask
        o = (jnp.einsum('bhnm,bmhv->bnhv', qk, vf)
             + jnp.einsum('bnhd,bhdv->bnhv', qf, s) * q_decay[None, :, :, None])
        s = s * c_decay[None, :, None, None] + jnp.einsum('bmhd,bmhv->bhdv', kf * k_decay[None, :, :, None], vf)
        return s, o

    s_fin, o = lax.scan(step, state0.astype(jnp.float32), (chunks(q), chunks(k), chunks(v)))
    return jnp.moveaxis(o, 0, 1).reshape(b, t, H_B, DV_B).astype(v.dtype), s_fin


def bi_retention(q, k, v, lg_f, lg_b, s0_f, s0_b):
    o_f, s_f = retention_chunkwise(q, k, v, lg_f, s0_f)
    fl = lambda a: jnp.flip(a, axis=1)
    o_b, s_b = retention_chunkwise(fl(q), fl(k), fl(v), lg_b, s0_b)
    return o_f + fl(o_b), s_f, s_b


def ret_output(o, g, w_out):
    o = rms_norm(o).reshape(o.shape[0], o.shape[1], E_B)
    return (o * jax.nn.silu(g)) @ w_out


def short_conv3(u, w):
    up = jnp.pad(u, ((0, 0), (1, 1), (0, 0)))
    return up[:, :-2] * w[0] + up[:, 1:-1] * w[1] + up[:, 2:] * w[2]


def conv_mixer(h, w_in, conv_w, w_out):
    bg, cg, u, z = jnp.split(h @ w_in, 4, axis=-1)
    y = bg * short_conv3(cg * u, conv_w)
    return (y * jax.nn.silu(z)) @ w_out


def setup_inputs(seed: int = 0) -> dict:
    key = jax.random.key(seed)
    ks = jax.random.split(key, 26)
    f32 = jnp.float32

    def nrm(k, shape, s):
        return jax.random.normal(k, shape, f32) * s

    D = D_MODEL
    heads_b = jnp.arange(H_B, dtype=f32)
    decay_init = -(5.0 + heads_b) * math.log(2.0)
    return {
        "x_prompt": nrm(ks[0], (BATCH, SEQ, D), 1.0),
        "x_sample": nrm(ks[1], (DEC_BATCH, DEC_SEQ, D), 1.0),
        "cache_k": nrm(ks[2], (DEC_BATCH, N_A, PAST_LEN, H_A, 2 * DH_A), 1.0),
        "cache_v": nrm(ks[3], (DEC_BATCH, N_A, PAST_LEN, H_A, DV_A), 1.0),
        "state_fwd": nrm(ks[4], (DEC_BATCH, N_B, H_B, DK_B, DV_B), 0.5),
        "state_bwd": nrm(ks[5], (DEC_BATCH, N_B, H_B, DK_B, DV_B), 0.5),
        "c": nrm(ks[6], (DEC_BATCH, D), 1.0),
        "c_ctx": nrm(ks[7], (D,), 1.0),
        "w_mod": nrm(ks[8], (DEPTH, D, 3 * D), 0.5 * D ** -0.5),
        "b_mod": nrm(ks[9], (DEPTH, 3 * D), 0.02),
        "ln_g": 1.0 + nrm(ks[10], (DEPTH, D), 0.02),
        "ln_b": nrm(ks[11], (DEPTH, D), 0.02),
        "w_in_a": nrm(ks[12], (N_A, D, 4 * E_A), D ** -0.5),
        "lam_a": nrm(ks[13], (N_A, 4, DH_A), 0.1),
        "subln_a": 1.0 + nrm(ks[14], (N_A, DV_A), 0.02),
        "w_out_a": nrm(ks[15], (N_A, E_A, D), BETA * E_A ** -0.5),
        "w_in_b": nrm(ks[16], (N_B, D, 2 * H_B * DK_B + 2 * E_B), D ** -0.5),
        "decay_fwd": decay_init[None] + nrm(ks[17], (N_B, H_B), 0.1),
        "decay_bwd": decay_init[None] + nrm(ks[18], (N_B, H_B), 0.1),
        "w_out_b": nrm(ks[19], (N_B, E_B, D), BETA * E_B ** -0.5),
        "w_in_c": nrm(ks[20], (N_C, D, 4 * E_C), D ** -0.5),
        "conv_c": nrm(ks[21], (N_C, CONV_W, E_C), CONV_W ** -0.5),
        "w_out_c": nrm(ks[22], (N_C, E_C, D), BETA * E_C ** -0.5),
    }


def reference(x_prompt, x_sample, cache_k, cache_v, state_fwd, state_bwd, c, c_ctx,
              w_mod, b_mod, ln_g, ln_b, w_in_a, lam_a, subln_a, w_out_a,
              w_in_b, decay_fwd, decay_bwd, w_out_b, w_in_c, conv_c, w_out_c):
    xp = x_prompt
    xs = x_sample
    b_s, t_s = xs.shape[0], xs.shape[1]
    l_c = cache_k.shape[2]
    new_k, new_v, new_sf, new_sb = [], [], [], []
    for i in range(DEPTH):
        kind, j = i % N_MIXERS, i // N_MIXERS
        sh_p, sc_p, g_p = ada_modulation(c_ctx[None], w_mod[i], b_mod[i])
        sh_s, sc_s, g_s = ada_modulation(c, w_mod[i], b_mod[i])
        hp = xp * (1 + sc_p) + sh_p
        hs = xs * (1 + sc_s) + sh_s
        if kind == 0:
            lam, lam_init = diff_lambda(lam_a[j], i)
            q, k, v, z = diff_project(hp, w_in_a[j])
            out_p = diff_output(diff_attention(q, k, v, lam), z, lam_init, subln_a[j], w_out_a[j])
            new_k.append(k.reshape(k.shape[0], k.shape[1], H_A, 2 * DH_A))
            new_v.append(v)
            q, k, v, z = diff_project(hs, w_in_a[j])
            cos, sin = axial_rope(t_s, DH_A)
            q = apply_rope(q, cos, sin)
            k = apply_rope(k, cos, sin)
            k_all = jnp.concatenate([k, cache_k[:, j].reshape(b_s, l_c, H_A, 2, DH_A).astype(k.dtype)], axis=1)
            v_all = jnp.concatenate([v, cache_v[:, j].astype(v.dtype)], axis=1)
            out_s = diff_output(diff_attention(q, k_all, v_all, lam), z, lam_init, subln_a[j], w_out_a[j])
        elif kind == 1:
            lg_f = log_decay(decay_fwd[j])
            lg_b = log_decay(decay_bwd[j])
            q, k, v, g = ret_project(hp, w_in_b[j])
            zero = jnp.zeros((q.shape[0], H_B, DK_B, DV_B), jnp.float32)
            o, s_f, s_b = bi_retention(q, k, v, lg_f, lg_b, zero, zero)
            out_p = ret_output(o, g, w_out_b[j])
            new_sf.append(s_f)
            new_sb.append(s_b)
            q, k, v, g = ret_project(hs, w_in_b[j])
            o, _, _ = bi_retention(q, k, v, lg_f, lg_b, state_fwd[:, j], state_bwd[:, j])
            out_s = ret_output(o, g, w_out_b[j])
        else:
            out_p = conv_mixer(hp, w_in_c[j], conv_c[j], w_out_c[j])
            out_s = conv_mixer(hs, w_in_c[j], conv_c[j], w_out_c[j])
        xp = layer_norm(ALPHA * xp + g_p * out_p, ln_g[i], ln_b[i])
        xs = layer_norm(ALPHA * xs + g_s * out_s, ln_g[i], ln_b[i])
    y_prompt = xp
    y_sample = xs
    new_cache_k = jnp.stack(new_k, axis=1)
    new_cache_v = jnp.stack(new_v, axis=1)
    new_state_fwd = jnp.stack(new_sf, axis=1)
    new_state_bwd = jnp.stack(new_sb, axis=1)
    return (y_prompt, y_sample, new_cache_k, new_cache_v, new_state_fwd, new_state_bwd)
```

```cpp
#include <hip/hip_runtime.h>
#include <hip/hip_cooperative_groups.h>
#include <cstdio>
#include <cmath>
namespace cg = cooperative_groups;

namespace pg8 {
#define PG8_LAS __attribute__((address_space(3)))
typedef unsigned short bf16_t;
typedef short bf16x8 __attribute__((ext_vector_type(8)));
typedef float f32x4 __attribute__((ext_vector_type(4)));
typedef unsigned u32x4 __attribute__((ext_vector_type(4)));
constexpr int BM = 256, BK = 64, HALF = 128, HTB = HALF * BK * 2  , STAGE_BYTES = 8 * HTB, NXCD = 8, WGM = 8;
__host__ __device__ __forceinline__ int lds_byte(int r, int c) { const int st = (r >> 4) * 2 + (c >> 5), rr = r & 15, cc = c & 31, ob = rr * 64 + cc * 2; return st * 1024 + (ob ^ (((ob >> 9) & 1) << 5)); }
__host__ __device__ __forceinline__ void stage_rc(int b, int& R, int& C) { const int st = b / 1024, sb = b % 1024, swz = sb ^ (((sb >> 9) & 1) << 5); R = (st >> 1) * 16 + swz / 64; C = (st & 1) * 32 + (swz % 64) / 2; }
__host__ __device__ __forceinline__ int perm32(int rho) { const int n = rho >> 4, i = rho & 15; return 8 * (i >> 2) + 4 * n + (i & 3); }

struct Unit { int pm, pn; };
struct Gemm { const bf16_t* A; const bf16_t* Bt; int M, N, K; };

struct StaticOrder {
    int nM, nN, nwg, G, c;
    __host__ __device__ void init(int M, int N, int G_, int c_) { nM = M / BM; nN = N / BM; nwg = nM * nN; G = G_; c = c_; }
    __host__ __device__ bool next(int i, Unit& u) const {
        const long L = (long)i * G + c; if (L >= nwg) return false;
        int wgid = (int)L; { const int q = nwg / NXCD, r = nwg % NXCD, xcd = wgid % NXCD, off = wgid / NXCD; wgid = (xcd < r ? xcd * (q + 1) : r * (q + 1) + (xcd - r) * q) + off; }
        const int nig = WGM * nN, gid = wgid / nig, fm = gid * WGM, gsz = (nM - fm) < WGM ? (nM - fm) : WGM;
        u.pm = fm + ((wgid % nig) % gsz); u.pn = (wgid % nig) / gsz; return true;
    }
    __device__ __forceinline__ void a_ready(const Unit&) const {}
    __device__ __forceinline__ void done(const Unit&) const {}
};
template <class Epi, class Sched, bool STAMP = false>
__device__ __forceinline__ void gemm_phase(PG8_LAS unsigned char* lds, const Gemm g, const Sched& S, const Epi& E, unsigned long long* stamps) {
    int tid_ = threadIdx.x; asm volatile("" : "+v"(tid_)); const int tid = tid_, wid = __builtin_amdgcn_readfirstlane(tid >> 6), lane = tid & 63, wr = wid >> 2, wc = wid & 3, fr = lane & 15, fq = lane >> 4;
    const int K = g.K, nt = K / BK;
    int ts_lo = 0, ts_hi = 0, nts = 0; const unsigned long long rt_entry = STAMP ? (unsigned long long)wall_clock64() : 0ull;
#define PG8_STAMP() do { if (STAMP && wid == 0 && nts < 64) { const unsigned long long _c = (unsigned long long)clock64(); \
        ts_lo = (lane == nts) ? (int)(unsigned)_c : ts_lo; ts_hi = (lane == nts) ? (int)(unsigned)(_c >> 32) : ts_hi; ++nts; } } while (0)
    PG8_STAMP();
    unsigned voffA[2], voffB[2];
#pragma unroll
    for (int i = 0; i < 2; ++i) { int R, C; stage_rc(tid * 16 + i * 8192, R, C); const int Rb = Epi::PERM ? ((R & ~31) + perm32(R & 31)) : R;
        voffA[i] = (unsigned)(R * K + C) * 2u; voffB[i] = (unsigned)(Rb * K + C) * 2u; }
    const size_t kstep = (size_t)(BK * 2);
    const size_t hstep = (size_t)HALF * K * 2;
    const size_t tstep = 2 * hstep;
    const unsigned ldsw = (unsigned)wid * 1024u;
    const int aoff = lds_byte(wr * 64 + fr, fq * 8), boff = lds_byte(wc * 32 + fr, fq * 8);
#define PG8_SA(b, h) (((b) * 2 + (h)) * HTB)
#define PG8_SB(b, h) ((4 + (b) * 2 + (h)) * HTB)
#define PG8_STAGE(bufoff, gbase, voff) do { _Pragma("unroll") for (int _i = 0; _i < 2; ++_i) \
        __builtin_amdgcn_global_load_lds((const unsigned*)((const char*)(gbase) + (voff)[_i]), (PG8_LAS unsigned*)(lds + (bufoff) + ldsw + _i * 8192), 16, 0, 0); } while (0)
#define PG8_LDA(dst, b, h) do { _Pragma("unroll") for (int m = 0; m < 4; ++m) _Pragma("unroll") for (int k = 0; k < 2; ++k) dst[m][k] = *(const PG8_LAS bf16x8*)(lds + PG8_SA(b, h) + aoff + m * 2048 + k * 1024); } while (0)
#define PG8_LDB(dst, b, h) do { _Pragma("unroll") for (int n = 0; n < 2; ++n) _Pragma("unroll") for (int k = 0; k < 2; ++k) dst[n][k] = *(const PG8_LAS bf16x8*)(lds + PG8_SB(b, h) + boff + n * 2048 + k * 1024); } while (0)
#define PG8_MMA(ai, bj, At, Bt) do { __builtin_amdgcn_s_setprio(1); _Pragma("unroll") for (int m = 0; m < 4; ++m) _Pragma("unroll") for (int n = 0; n < 2; ++n) _Pragma("unroll") for (int k = 0; k < 2; ++k) \
        acc[ai][bj][m][n] = __builtin_amdgcn_mfma_f32_16x16x32_bf16(Bt[n][k], At[m][k], acc[ai][bj][m][n], 0, 0, 0); __builtin_amdgcn_s_setprio(0); } while (0)
#define PG8_WAIT_V(n) asm volatile("s_waitcnt vmcnt(" #n ")" ::: "memory")
#define PG8_WAIT_L(n) asm volatile("s_waitcnt lgkmcnt(" #n ")" ::: "memory")
#define PG8_BAR __builtin_amdgcn_s_barrier()
#define PG8_SCHED __builtin_amdgcn_sched_barrier(0)
    Unit cur, nxt; int ui = 0;
    if (!S.next(0, cur)) return;
    f32x4 acc[2][2][4][2];
#pragma unroll
    for (int a = 0; a < 2; ++a)
#pragma unroll
        for (int b = 0; b < 2; ++b)
#pragma unroll
            for (int m = 0; m < 4; ++m)
#pragma unroll
                for (int n = 0; n < 2; ++n) acc[a][b][m][n] = (f32x4){0.f, 0.f, 0.f, 0.f};
    bf16x8 At[4][2], B0[2][2], B1[2][2];
    const char* cA = (const char*)g.A + (size_t)cur.pm * tstep; const char* cB = (const char*)g.Bt + (size_t)cur.pn * tstep;
    S.a_ready(cur);
    PG8_STAGE(PG8_SB(0, 0), cB, voffB); PG8_STAGE(PG8_SA(0, 0), cA, voffA); PG8_STAGE(PG8_SB(0, 1), cB + hstep, voffB); PG8_STAGE(PG8_SA(0, 1), cA + hstep, voffA);
    if (wr == 1) PG8_BAR;
    PG8_WAIT_V(4); PG8_BAR;
    PG8_STAGE(PG8_SB(1, 0), cB + kstep, voffB); PG8_STAGE(PG8_SA(1, 0), cA + kstep, voffA); PG8_STAGE(PG8_SB(1, 1), cB + hstep + kstep, voffB);
    PG8_WAIT_V(6); PG8_BAR;
    PG8_STAMP();
    for (;;) {
        const bool has_next = S.next(ui + 1, nxt);
        const char* nA = has_next ? (const char*)g.A + (size_t)nxt.pm * tstep : cA; const char* nB = has_next ? (const char*)g.Bt + (size_t)nxt.pn * tstep : cB;
        for (int t = 0; t < nt; t += 2) {
            const bool last = (t == nt - 2);
            const char* a1 = cA + (size_t)(t + 1) * kstep;
            const char* a2 = last ? nA : cA + (size_t)(t + 2) * kstep; const char* b2 = last ? nB : cB + (size_t)(t + 2) * kstep;
            const char* a3 = a2 + kstep; const char* b3 = b2 + kstep;
            if (last && has_next) S.a_ready(nxt);
            PG8_LDB(B0, 0, 0); PG8_SCHED; PG8_LDA(At, 0, 0); PG8_STAGE(PG8_SA(1, 1), a1 + hstep, voffA);
            PG8_WAIT_L(8); PG8_BAR; PG8_WAIT_L(0); PG8_MMA(0, 0, At, B0); PG8_BAR; PG8_SCHED;
            PG8_LDB(B1, 0, 1); PG8_STAGE(PG8_SB(0, 0), b2, voffB);
            PG8_BAR; PG8_WAIT_L(0); PG8_MMA(0, 1, At, B1); PG8_BAR;
            PG8_LDA(At, 0, 1); PG8_STAGE(PG8_SA(0, 0), a2, voffA);
            PG8_BAR; PG8_WAIT_L(0); PG8_MMA(1, 0, At, B0); PG8_BAR; PG8_SCHED;
            PG8_STAGE(PG8_SB(0, 1), b2 + hstep, voffB);
            PG8_WAIT_V(6); PG8_BAR; PG8_MMA(1, 1, At, B1); PG8_BAR;
            PG8_LDB(B0, 1, 0); PG8_SCHED; PG8_LDA(At, 1, 0); PG8_STAGE(PG8_SA(0, 1), a2 + hstep, voffA);
            PG8_WAIT_L(8); PG8_BAR; PG8_WAIT_L(0); PG8_MMA(0, 0, At, B0); PG8_BAR; PG8_SCHED;
            PG8_LDB(B1, 1, 1); PG8_STAGE(PG8_SB(1, 0), b3, voffB);
            PG8_BAR; PG8_WAIT_L(0); PG8_MMA(0, 1, At, B1); PG8_BAR;
            PG8_LDA(At, 1, 1); PG8_STAGE(PG8_SA(1, 0), a3, voffA);
            PG8_BAR; PG8_WAIT_L(0); PG8_MMA(1, 0, At, B0); PG8_BAR; PG8_SCHED;
            PG8_STAGE(PG8_SB(1, 1), b3 + hstep, voffB);
            PG8_WAIT_V(6); PG8_BAR; PG8_MMA(1, 1, At, B1); PG8_BAR;
        }
        PG8_STAMP();
        if constexpr (!Epi::AFTER_DRAIN) { E(acc, cur, wr, wc, fr, fq); S.done(cur); }
        PG8_STAMP();
        if (!has_next) break;
#pragma unroll
        for (int a = 0; a < 2; ++a)
#pragma unroll
            for (int b = 0; b < 2; ++b)
#pragma unroll
                for (int m = 0; m < 4; ++m)
#pragma unroll
                    for (int n = 0; n < 2; ++n) acc[a][b][m][n] = (f32x4){0.f, 0.f, 0.f, 0.f};
        cur = nxt; cA = nA; cB = nB; ++ui;
    }
    PG8_WAIT_V(0);
    if (wr == 0) PG8_BAR;
    PG8_BAR;
    if constexpr (Epi::AFTER_DRAIN) { E.fused(acc, cur, wr, wc, fr, fq, lds, wid, lane); S.done(cur); }
    PG8_STAMP();
    if (STAMP && wid == 0) { stamps[lane] = lane < nts ? (((unsigned long long)(unsigned)ts_hi << 32) | (unsigned)ts_lo) : 0ull;
        if (lane == 62) stamps[62] = rt_entry; if (lane == 63) stamps[63] = (unsigned long long)wall_clock64(); }
#undef PG8_STAMP
#undef PG8_SA
#undef PG8_SB
#undef PG8_STAGE
#undef PG8_LDA
#undef PG8_LDB
#undef PG8_MMA
#undef PG8_WAIT_V
#undef PG8_WAIT_L
#undef PG8_BAR
#undef PG8_SCHED
}
}

using pg8::bf16x8; using pg8::f32x4;
typedef unsigned short u16;
typedef unsigned u32x2 __attribute__((ext_vector_type(2)));
#define LAS __attribute__((address_space(3)))

constexpr int NTHREADS = 512;
constexpr int LDS_BYTES = 136192;
constexpr float LOG2E = 1.4426950408889634f;
constexpr float ALPHA_F = 1.681792830507429f;

constexpr size_t OUT_NCK = 8388608, OUT_NCV = 16777216, OUT_NSF = 25165824, OUT_NSB = 33554432;
constexpr size_t WS_WT_A1 = 0, WS_WT_OA1 = 8388608, WS_WT_B = 10485760, WS_WT_OB = 23068672, WS_WT_C = 27262976, WS_WT_OC = 35651584,
                 WS_MOD = 37748736, WS_ROPE = 38010880, WS_ABUF = 38273024, WS_WT_A0 = 55050240, WS_WT_OA0 = 63438848, WS_UATT = 65536000;
constexpr size_t UA_Q = WS_UATT, UA_Z = WS_UATT + 16777216, UA_KC = WS_UATT + 33554432, UA_KL = WS_UATT + 41943040, UA_VTC = WS_UATT + 52428800, UA_VTL = WS_UATT + 60817408;
constexpr size_t UR_QR = WS_WT_A0, UR_KR = UR_QR + 16777216, UR_KTR = UR_QR + 33554432, UR_VTR = UR_QR + 50331648, UR_G = UR_QR + 83886080, UR_O = UR_QR + 117440512, UR_SB = UR_QR + 150994944;
constexpr size_t UC_T1 = WS_UATT, UC_PC = WS_UATT + 16777216;
constexpr size_t WS_NEEDED = UR_SB + 50331648;

struct Prm {
    const float* in[23];
    float* out;
    char* ws;
    float lam_init[2];
};

__device__ __forceinline__ u16 f2bf(float f) { unsigned u = __float_as_uint(f); u += 0x7fffu + ((u >> 16) & 1u); return (u16)(u >> 16); }
__device__ __forceinline__ float bf2f(u16 h) { return __uint_as_float(((unsigned)h) << 16); }
__device__ __forceinline__ unsigned pk2(float lo, float hi) { return (unsigned)f2bf(lo) | ((unsigned)f2bf(hi) << 16); }
__device__ __forceinline__ u32x2 pk4(f32x4 v) { u32x2 r; r.x = pk2(v[0], v[1]); r.y = pk2(v[2], v[3]); return r; }
__device__ __forceinline__ float silu_f(float x) { return x / (1.0f + __expf(-x)); }
__device__ __forceinline__ float ex2(float x) { return __builtin_amdgcn_exp2f(x); }
__device__ __forceinline__ int tid_l() { int t = threadIdx.x; asm volatile("" : "+v"(t)); return t; }
__device__ __forceinline__ int row_n5(int r) { return r < 4096 ? 0 : 1 + ((r - 4096) >> 10); }
#define MFMA16(a, b, c) __builtin_amdgcn_mfma_f32_16x16x32_bf16((a), (b), (c), 0, 0, 0)

struct Epi {
    static constexpr bool PERM = false, AFTER_DRAIN = false;
    int kind; int layer; int j;
    const Prm* p;
    __device__ __forceinline__ void operator()(const f32x4 (&acc)[2][2][4][2], const pg8::Unit& u, int wr, int wc, int fr, int fq) const {
        char* ws = p->ws;
        const int pm = u.pm, pn = u.pn;
        if (kind == 0) {
            const bool lat = pm >= 16;
            const int b = lat ? ((pm - 16) >> 2) : pm;
            const int t0 = lat ? (((pm - 16) & 3) << 8) : 0;
            if (pn < 8) {
                const bool isq = pn < 4;
                const int G = ((pn & 3) << 2) + wc, h = G >> 1, mm = G & 1;
                const float* rope = (const float*)(ws + WS_ROPE);
#pragma unroll
                for (int ai = 0; ai < 2; ++ai)
#pragma unroll
                    for (int m = 0; m < 4; ++m) {
                        const int rl = ai * 128 + wr * 64 + m * 16 + fr;
                        const int r = pm * 256 + rl, t = t0 + rl;
#pragma unroll
                        for (int n = 0; n < 2; ++n) {
                            const int dd = 16 * n + 4 * fq;
                            f32x4 x1 = acc[ai][0][m][n], x2 = acc[ai][1][m][n], o1, o2;
                            if (lat) {
                                const f32x4 cs0 = *(const f32x4*)(rope + ((size_t)t * 32 + dd) * 2), cs1 = *(const f32x4*)(rope + ((size_t)t * 32 + dd) * 2 + 4);
                                const float c0 = cs0[0], s0 = cs0[1], c1 = cs0[2], s1 = cs0[3], c2 = cs1[0], s2 = cs1[1], c3 = cs1[2], s3 = cs1[3];
                                o1[0] = x1[0] * c0 - x2[0] * s0; o2[0] = x1[0] * s0 + x2[0] * c0;
                                o1[1] = x1[1] * c1 - x2[1] * s1; o2[1] = x1[1] * s1 + x2[1] * c1;
                                o1[2] = x1[2] * c2 - x2[2] * s2; o2[2] = x1[2] * s2 + x2[2] * c2;
                                o1[3] = x1[3] * c3 - x2[3] * s3; o2[3] = x1[3] * s3 + x2[3] * c3;
                            } else { o1 = x1; o2 = x2; }
                            if (isq) {
                                u16* q = (u16*)(ws + UA_Q) + (size_t)r * 1024 + G * 64 + dd;
                                *(u32x2*)q = pk4(o1); *(u32x2*)(q + 32) = pk4(o2);
                            } else if (lat) {
                                u16* k = (u16*)(ws + UA_KL) + ((size_t)((b * 8 + h) * 2 + mm) * 1280 + t) * 64 + dd;
                                *(u32x2*)k = pk4(o1); *(u32x2*)(k + 32) = pk4(o2);
                            } else {
                                u16* k = (u16*)(ws + UA_KC) + ((size_t)((b * 8 + h) * 2 + mm) * 256 + t) * 64 + dd;
                                *(u32x2*)k = pk4(o1); *(u32x2*)(k + 32) = pk4(o2);
                                float* o = p->out + OUT_NCK + ((size_t)(b * 2 + j) * 256 + t) * 1024 + G * 64 + dd;
                                *(f32x4*)o = o1; *(f32x4*)(o + 32) = o2;
                            }
                        }
                    }
            } else if (pn < 12) {
#pragma unroll
                for (int ai = 0; ai < 2; ++ai)
#pragma unroll
                    for (int m = 0; m < 4; ++m) {
                        const int rl = ai * 128 + wr * 64 + m * 16 + fr;
                        const int t = t0 + rl;
#pragma unroll
                        for (int bj = 0; bj < 2; ++bj)
#pragma unroll
                            for (int n = 0; n < 2; ++n) {
                                const int c = (pn - 8) * 256 + bj * 128 + wc * 32 + n * 16 + 4 * fq;
                                const int h = c >> 7, dv = c & 127;
                                const f32x4 v = acc[ai][bj][m][n];
                                if (lat) {
                                    u16* vt = (u16*)(ws + UA_VTL) + ((size_t)(b * 8 + h) * 128 + dv) * 1280 + t;
                                    vt[0] = f2bf(v[0]); vt[1280] = f2bf(v[1]); vt[2560] = f2bf(v[2]); vt[3840] = f2bf(v[3]);
                                } else {
                                    u16* vt = (u16*)(ws + UA_VTC) + ((size_t)(b * 8 + h) * 128 + dv) * 256 + t;
                                    vt[0] = f2bf(v[0]); vt[256] = f2bf(v[1]); vt[512] = f2bf(v[2]); vt[768] = f2bf(v[3]);
                                    *(f32x4*)(p->out + OUT_NCV + ((size_t)(b * 2 + j) * 256 + t) * 1024 + c) = v;
                                }
                            }
                    }
            } else {
#pragma unroll
                for (int ai = 0; ai < 2; ++ai)
#pragma unroll
                    for (int m = 0; m < 4; ++m) {
                        const int r = pm * 256 + ai * 128 + wr * 64 + m * 16 + fr;
#pragma unroll
                        for (int bj = 0; bj < 2; ++bj)
#pragma unroll
                            for (int n = 0; n < 2; ++n) {
                                const int c = (pn - 12) * 256 + bj * 128 + wc * 32 + n * 16 + 4 * fq;
                                f32x4 v = acc[ai][bj][m][n];
                                v[0] = silu_f(v[0]); v[1] = silu_f(v[1]); v[2] = silu_f(v[2]); v[3] = silu_f(v[3]);
                                *(u32x2*)((u16*)(ws + UA_Z) + (size_t)r * 1024 + c) = pk4(v);
                            }
                    }
            }
        } else if (kind == 1) {
#pragma unroll
            for (int ai = 0; ai < 2; ++ai)
#pragma unroll
                for (int m = 0; m < 4; ++m) {
                    const int r = pm * 256 + ai * 128 + wr * 64 + m * 16 + fr;
#pragma unroll
                    for (int bj = 0; bj < 2; ++bj)
#pragma unroll
                        for (int n = 0; n < 2; ++n) {
                            const int cb = bj * 128 + wc * 32 + n * 16 + 4 * fq;
                            f32x4 v = acc[ai][bj][m][n];
                            if (pn < 4) {
                                *(u32x2*)((u16*)(ws + UR_QR) + (size_t)r * 1024 + pn * 256 + cb) = pk4(v);
                            } else if (pn < 8) {
                                const int c = (pn - 4) * 256 + cb;
                                v = v * 0.0625f;
                                *(u32x2*)((u16*)(ws + UR_KR) + (size_t)r * 1024 + c) = pk4(v);
                                u16* kt = (u16*)(ws + UR_KTR) + (size_t)c * 8192 + r;
                                kt[0] = f2bf(v[0]); kt[8192] = f2bf(v[1]); kt[16384] = f2bf(v[2]); kt[24576] = f2bf(v[3]);
                            } else if (pn < 16) {
                                const int c = (pn - 8) * 256 + cb;
                                u16* vt = (u16*)(ws + UR_VTR) + (size_t)c * 8192 + r;
                                vt[0] = f2bf(v[0]); vt[8192] = f2bf(v[1]); vt[16384] = f2bf(v[2]); vt[24576] = f2bf(v[3]);
                            } else {
                                const int c = (pn - 16) * 256 + cb;
                                v[0] = silu_f(v[0]); v[1] = silu_f(v[1]); v[2] = silu_f(v[2]); v[3] = silu_f(v[3]);
                                *(u32x2*)((u16*)(ws + UR_G) + (size_t)r * 2048 + c) = pk4(v);
                            }
                        }
                }
        } else if (kind == 2) {
#pragma unroll
            for (int ai = 0; ai < 2; ++ai)
#pragma unroll
                for (int m = 0; m < 4; ++m) {
                    const int r = pm * 256 + ai * 128 + wr * 64 + m * 16 + fr;
                    const int e = pn * 64 + wc * 16 + 4 * fq;
                    const f32x4 bg = acc[ai][0][m][0], cgv = acc[ai][0][m][1], uu = acc[ai][1][m][0], z = acc[ai][1][m][1];
                    f32x4 t1, pc;
#pragma unroll
                    for (int q = 0; q < 4; ++q) { t1[q] = bg[q] * silu_f(z[q]); pc[q] = cgv[q] * uu[q]; }
                    *(u32x2*)((u16*)(ws + UC_T1) + (size_t)r * 1024 + e) = pk4(t1);
                    *(u32x2*)((u16*)(ws + UC_PC) + (size_t)r * 1024 + e) = pk4(pc);
                }
        } else {
            const float* xin = (layer == 0) ? (pm < 16 ? p->in[0] : p->in[1] - (size_t)4096 * 1024) : p->out;
            const float* gate = (const float*)(ws + WS_MOD) + ((size_t)layer * 5 + (pm < 16 ? 0 : 1 + ((pm - 16) >> 2))) * 3072 + 2048;
#pragma unroll
            for (int ai = 0; ai < 2; ++ai)
#pragma unroll
                for (int m = 0; m < 4; ++m) {
                    const int r = pm * 256 + ai * 128 + wr * 64 + m * 16 + fr;
#pragma unroll
                    for (int bj = 0; bj < 2; ++bj)
#pragma unroll
                        for (int n = 0; n < 2; ++n) {
                            const int c = pn * 256 + bj * 128 + wc * 32 + n * 16 + 4 * fq;
                            const f32x4 xv = *(const f32x4*)(xin + (size_t)r * 1024 + c);
                            const f32x4 gv = *(const f32x4*)(gate + c);
                            *(f32x4*)(p->out + (size_t)r * 1024 + c) = xv * ALPHA_F + gv * acc[ai][bj][m][n];
                        }
                }
        }
    }
};

__device__ __forceinline__ int perm_col(int kind, int n) {
    if (kind == 1) {
        if (n >= 2048) return n;
        const int blk = n >> 8, w = n & 255, Gl = w >> 6, half = (w >> 5) & 1, dd = w & 31;
        return (blk << 8) + half * 128 + Gl * 32 + dd;
    } else if (kind == 2) {
        const int part = n >> 10, e = n & 1023, blk = e >> 6, el = e & 63, wc = el >> 4, f = el & 15;
        return blk * 256 + (part >> 1) * 128 + wc * 32 + (part & 1) * 16 + f;
    }
    return n;
}

__device__ __forceinline__ void phase_p0a(const Prm& p, LAS unsigned char* lds) {
    const int tid = tid_l();
    LAS u16* sT = (LAS u16*)lds;
    LAS float* scond = (LAS float*)(lds + 9216);
    LAS float* red = (LAS float*)(lds + 9216 + 20480);
    for (int i = tid; i < 5120; i += NTHREADS) {
        const int n = i >> 10, k = i & 1023;
        const float v = (n == 0) ? p.in[7][k] : p.in[6][(n - 1) * 1024 + k];
        scond[i] = silu_f(v);
    }
    __syncthreads();
    for (int mi = 0; mi < 8; ++mi) {
        const float* W; size_t off; int K, N, kind;
        switch (mi) {
            case 0: W = p.in[12]; off = WS_WT_A0; K = 1024; N = 4096; kind = 1; break;
            case 1: W = p.in[12] + (size_t)1024 * 4096; off = WS_WT_A1; K = 1024; N = 4096; kind = 1; break;
            case 2: W = p.in[15]; off = WS_WT_OA0; K = 1024; N = 1024; kind = 0; break;
            case 3: W = p.in[15] + (size_t)1024 * 1024; off = WS_WT_OA1; K = 1024; N = 1024; kind = 0; break;
            case 4: W = p.in[16]; off = WS_WT_B; K = 1024; N = 6144; kind = 0; break;
            case 5: W = p.in[19]; off = WS_WT_OB; K = 2048; N = 1024; kind = 0; break;
            case 6: W = p.in[20]; off = WS_WT_C; K = 1024; N = 4096; kind = 2; break;
            default: W = p.in[22]; off = WS_WT_OC; K = 1024; N = 1024; kind = 0; break;
        }
        u16* WT = (u16*)(p.ws + off);
        const int ntn = N >> 6, ntiles = (K >> 6) * ntn;
        for (int tile = blockIdx.x; tile < ntiles; tile += gridDim.x) {
            const int k0 = (tile / ntn) << 6, n0 = (tile % ntn) << 6;
#pragma unroll
            for (int i = 0; i < 2; ++i) {
                const int row = (tid >> 4) + 32 * i, col4 = (tid & 15) * 4;
                const f32x4 v = *(const f32x4*)(W + (size_t)(k0 + row) * N + n0 + col4);
                sT[(col4 + 0) * 72 + row] = f2bf(v[0]); sT[(col4 + 1) * 72 + row] = f2bf(v[1]);
                sT[(col4 + 2) * 72 + row] = f2bf(v[2]); sT[(col4 + 3) * 72 + row] = f2bf(v[3]);
            }
            __syncthreads();
            const int n = tid >> 3, ks = (tid & 7) * 8;
            const bf16x8 v = *(const LAS bf16x8*)(sT + n * 72 + ks);
            *(bf16x8*)(WT + (size_t)perm_col(kind, n0 + n) * K + k0 + ks) = v;
            __syncthreads();
        }
    }
    for (int u = blockIdx.x; u < 192; u += gridDim.x) {
        const int i = u / 48, c0 = (u % 48) * 64;
        const int col = tid & 63, ks = tid >> 6;
        const float* w = p.in[8] + (size_t)i * 1024 * 3072 + (size_t)(ks * 128) * 3072 + c0 + col;
        float a0 = 0.f, a1 = 0.f, a2 = 0.f, a3 = 0.f, a4 = 0.f;
#pragma unroll 8
        for (int k = 0; k < 128; ++k) {
            const float wv = w[(size_t)k * 3072];
            const int kk = ks * 128 + k;
            a0 += scond[kk] * wv; a1 += scond[1024 + kk] * wv; a2 += scond[2048 + kk] * wv; a3 += scond[3072 + kk] * wv; a4 += scond[4096 + kk] * wv;
        }
        red[(ks * 5 + 0) * 64 + col] = a0; red[(ks * 5 + 1) * 64 + col] = a1; red[(ks * 5 + 2) * 64 + col] = a2;
        red[(ks * 5 + 3) * 64 + col] = a3; red[(ks * 5 + 4) * 64 + col] = a4;
        __syncthreads();
        if (tid < 320) {
            const int n = tid >> 6, cc = tid & 63;
            float s = p.in[9][i * 3072 + c0 + cc];
#pragma unroll
            for (int q = 0; q < 8; ++q) s += red[(q * 5 + n) * 64 + cc];
            ((float*)(p.ws + WS_MOD))[((size_t)i * 5 + n) * 3072 + c0 + cc] = s;
        }
        __syncthreads();
    }
    for (int e = blockIdx.x * NTHREADS + tid; e < 32768; e += gridDim.x * NTHREADS) {
        const int t = e >> 5, dd = e & 31, f = dd & 15;
        const float inv = exp2f(-(float)f * (13.287712379549449f / 16.0f));
        const float pos = (dd < 16) ? (float)(t >> 6) : (float)(t & 63);
        const float ang = pos * inv;
        float* o = (float*)(p.ws + WS_ROPE) + (size_t)e * 2;
        o[0] = cosf(ang); o[1] = sinf(ang);
    }
}

__device__ __forceinline__ void cache_convert(const Prm& p, int j) {
    const int gt = blockIdx.x * NTHREADS + tid_l(), gs = gridDim.x * NTHREADS;
    for (int idx = gt; idx < 4 * 256 * 8 * 16; idx += gs) {
        const int d8 = idx & 15, h = (idx >> 4) & 7, s = (idx >> 7) & 255, b = idx >> 15;
        const float* src = p.in[2] + ((size_t)((b * 2 + j) * 256 + s) * 8 + h) * 128 + d8 * 8;
        const f32x4 v0 = *(const f32x4*)src, v1 = *(const f32x4*)(src + 4);
        const int mm = d8 >> 3, d = (d8 & 7) * 8;
        u16* dst = (u16*)(p.ws + UA_KL) + ((size_t)((b * 8 + h) * 2 + mm) * 1280 + 1024 + s) * 64 + d;
        pg8::u32x4 o; o.x = pk2(v0[0], v0[1]); o.y = pk2(v0[2], v0[3]); o.z = pk2(v1[0], v1[1]); o.w = pk2(v1[2], v1[3]);
        *(pg8::u32x4*)dst = o;
    }
    for (int idx = gt; idx < 4 * 256 * 8 * 16; idx += gs) {
        const int s = idx & 255, d8 = (idx >> 8) & 15, h = (idx >> 12) & 7, b = idx >> 15;
        const float* src = p.in[3] + ((size_t)((b * 2 + j) * 256 + s) * 8 + h) * 128 + d8 * 8;
        const f32x4 v0 = *(const f32x4*)src, v1 = *(const f32x4*)(src + 4);
        u16* dst = (u16*)(p.ws + UA_VTL) + ((size_t)(b * 8 + h) * 128 + d8 * 8) * 1280 + 1024 + s;
        dst[0] = f2bf(v0[0]); dst[1280] = f2bf(v0[1]); dst[2560] = f2bf(v0[2]); dst[3840] = f2bf(v0[3]);
        dst[5120] = f2bf(v1[0]); dst[6400] = f2bf(v1[1]); dst[7680] = f2bf(v1[2]); dst[8960] = f2bf(v1[3]);
    }
}

__device__ __forceinline__ void phase_p0b(const Prm& p) {
    const float* mod = (const float*)(p.ws + WS_MOD);
    u16* A = (u16*)(p.ws + WS_ABUF);
    for (int idx = blockIdx.x * NTHREADS + tid_l(); idx < 8192 * 128; idx += gridDim.x * NTHREADS) {
        const int r = idx >> 7, c = (idx & 127) * 8;
        const float* x = (r < 4096) ? p.in[0] + (size_t)r * 1024 + c : p.in[1] + (size_t)(r - 4096) * 1024 + c;
        const float* md = mod + (size_t)row_n5(r) * 3072;
        const f32x4 x0 = *(const f32x4*)x, x1 = *(const f32x4*)(x + 4);
        const f32x4 sh0 = *(const f32x4*)(md + c), sh1 = *(const f32x4*)(md + c + 4), sc0 = *(const f32x4*)(md + 1024 + c), sc1 = *(const f32x4*)(md + 1024 + c + 4);
        const f32x4 h0 = x0 * (sc0 + 1.0f) + sh0, h1 = x1 * (sc1 + 1.0f) + sh1;
        pg8::u32x4 o; o.x = pk2(h0[0], h0[1]); o.y = pk2(h0[2], h0[3]); o.z = pk2(h1[0], h1[1]); o.w = pk2(h1[2], h1[3]);
        *(pg8::u32x4*)(A + (size_t)r * 1024 + c) = o;
    }
}

__device__ __forceinline__ void phase_ln(const Prm& p, int li, int nxt) {
    const int tid = tid_l(), w = tid >> 6, lane = tid & 63;
    const float* g = p.in[10] + li * 1024; const float* bb = p.in[11] + li * 1024;
    u16* A = (u16*)(p.ws + WS_ABUF);
    for (int r = blockIdx.x * 8 + w; r < 8192; r += gridDim.x * 8) {
        float* x = p.out + (size_t)r * 1024;
        f32x4 v[4];
        float s = 0.f;
#pragma unroll
        for (int q = 0; q < 4; ++q) { v[q] = *(const f32x4*)(x + q * 256 + lane * 4); s += v[q][0] + v[q][1] + v[q][2] + v[q][3]; }
#pragma unroll
        for (int o = 32; o; o >>= 1) s += __shfl_xor(s, o, 64);
        const float mu = s * (1.0f / 1024.0f);
        float ss = 0.f;
#pragma unroll
        for (int q = 0; q < 4; ++q) { v[q] = v[q] - mu; ss += v[q][0] * v[q][0] + v[q][1] * v[q][1] + v[q][2] * v[q][2] + v[q][3] * v[q][3]; }
#pragma unroll
        for (int o = 32; o; o >>= 1) ss += __shfl_xor(ss, o, 64);
        const float rstd = rsqrtf(ss * (1.0f / 1024.0f) + 1e-5f);
        const float* md = (const float*)(p.ws + WS_MOD) + ((size_t)(nxt < 4 ? nxt : 0) * 5 + row_n5(r)) * 3072;
#pragma unroll
        for (int q = 0; q < 4; ++q) {
            const int c = q * 256 + lane * 4;
            const f32x4 xn = v[q] * rstd * *(const f32x4*)(g + c) + *(const f32x4*)(bb + c);
            *(f32x4*)(x + c) = xn;
            if (nxt < 4) {
                const f32x4 h = xn * (*(const f32x4*)(md + 1024 + c) + 1.0f) + *(const f32x4*)(md + c);
                *(u32x2*)(A + (size_t)r * 1024 + c) = pk4(h);
            }
        }
    }
}

__device__ __forceinline__ void phase_attn(const Prm& p, int j, LAS unsigned char* lds) {
    const int tid = tid_l(), w = tid >> 6, lane = tid & 63, lr = lane & 15, lq = lane >> 4;
    LAS u16* sm = (LAS u16*)lds;
    LAS u16* pb = sm + 36864 + w * 2304;
    float la = p.in[13][j * 256 + lane] * p.in[13][j * 256 + 64 + lane], lb = p.in[13][j * 256 + 128 + lane] * p.in[13][j * 256 + 192 + lane];
#pragma unroll
    for (int o = 32; o; o >>= 1) { la += __shfl_xor(la, o, 64); lb += __shfl_xor(lb, o, 64); }
    const float lam_init = p.lam_init[j];
    const float lamv = __expf(la) - __expf(lb) + lam_init;
    const float* subln = p.in[14] + j * 128;
    const u16* Q = (const u16*)(p.ws + UA_Q);
    const u16* Z = (const u16*)(p.ws + UA_Z);
    u16* A = (u16*)(p.ws + WS_ABUF);
    const float SC = 0.125f * LOG2E;
    for (int it = blockIdx.x; it < 512; it += gridDim.x) {
        int b, h, r0, nkeys; const u16* Kb; const u16* Vb;
        if (it < 256) { b = it >> 6; h = (it >> 3) & 7; r0 = 4096 + b * 1024 + (it & 7) * 128; nkeys = 1280;
            Kb = (const u16*)(p.ws + UA_KL) + (size_t)(b * 8 + h) * 2 * 1280 * 64; Vb = (const u16*)(p.ws + UA_VTL) + (size_t)(b * 8 + h) * 128 * 1280; }
        else { const int i2 = it - 256; b = i2 >> 4; h = (i2 >> 1) & 7; r0 = b * 256 + (i2 & 1) * 128; nkeys = 256;
            Kb = (const u16*)(p.ws + UA_KC) + (size_t)(b * 8 + h) * 2 * 256 * 64; Vb = (const u16*)(p.ws + UA_VTC) + (size_t)(b * 8 + h) * 128 * 256; }
        const int row_a = r0 + w * 16 + lr;
        bf16x8 qf[2][2];
#pragma unroll
        for (int m = 0; m < 2; ++m)
#pragma unroll
            for (int ks = 0; ks < 2; ++ks) qf[m][ks] = *(const bf16x8*)(Q + (size_t)row_a * 1024 + h * 128 + m * 64 + ks * 32 + lq * 8);
        f32x4 O[2][8];
        float mrow[2][4], lsum[2][4];
#pragma unroll
        for (int m = 0; m < 2; ++m) {
#pragma unroll
            for (int n = 0; n < 8; ++n) O[m][n] = (f32x4){0.f, 0.f, 0.f, 0.f};
#pragma unroll
            for (int i = 0; i < 4; ++i) { mrow[m][i] = -1e30f; lsum[m][i] = 0.f; }
        }
        const int ntiles = nkeys >> 6;
        const int krow = tid >> 3, kseg = (tid & 7) * 8, vrow = tid >> 2, vseg = (tid & 3) * 16;
        bf16x8 g0, g1, g2, g3;
        g0 = *(const bf16x8*)(Kb + (size_t)krow * 64 + kseg);
        g1 = *(const bf16x8*)(Kb + (size_t)(nkeys + krow) * 64 + kseg);
        g2 = *(const bf16x8*)(Vb + (size_t)vrow * nkeys + vseg);
        g3 = *(const bf16x8*)(Vb + (size_t)vrow * nkeys + vseg + 8);
        *(LAS bf16x8*)(sm + krow * 72 + kseg) = g0; *(LAS bf16x8*)(sm + 4608 + krow * 72 + kseg) = g1;
        *(LAS bf16x8*)(sm + 9216 + vrow * 72 + vseg) = g2; *(LAS bf16x8*)(sm + 9216 + vrow * 72 + vseg + 8) = g3;
        __syncthreads();
        for (int kt = 0; kt < ntiles; ++kt) {
            const int cur = kt & 1;
            const bool more = kt + 1 < ntiles;
            if (more) {
                const int k0 = (kt + 1) * 64;
                g0 = *(const bf16x8*)(Kb + (size_t)(k0 + krow) * 64 + kseg);
                g1 = *(const bf16x8*)(Kb + (size_t)(nkeys + k0 + krow) * 64 + kseg);
                g2 = *(const bf16x8*)(Vb + (size_t)vrow * nkeys + k0 + vseg);
                g3 = *(const bf16x8*)(Vb + (size_t)vrow * nkeys + k0 + vseg + 8);
            }
            const LAS u16* bK = sm + cur * 18432; const LAS u16* bV = bK + 9216;
            f32x4 s[2][4];
#pragma unroll
            for (int m = 0; m < 2; ++m)
#pragma unroll
                for (int n = 0; n < 4; ++n) s[m][n] = (f32x4){0.f, 0.f, 0.f, 0.f};
#pragma unroll
            for (int m = 0; m < 2; ++m)
#pragma unroll
                for (int ks = 0; ks < 2; ++ks)
#pragma unroll
                    for (int n = 0; n < 4; ++n) {
                        const bf16x8 kf = *(const LAS bf16x8*)(bK + m * 4608 + (n * 16 + lr) * 72 + ks * 32 + lq * 8);
                        s[m][n] = MFMA16(qf[m][ks], kf, s[m][n]);
                    }
#pragma unroll
            for (int m = 0; m < 2; ++m) {
#pragma unroll
                for (int i = 0; i < 4; ++i) {
                    float mx = -1e30f;
#pragma unroll
                    for (int n = 0; n < 4; ++n) { s[m][n][i] *= SC; mx = fmaxf(mx, s[m][n][i]); }
                    mx = fmaxf(mx, __shfl_xor(mx, 1, 64)); mx = fmaxf(mx, __shfl_xor(mx, 2, 64));
                    mx = fmaxf(mx, __shfl_xor(mx, 4, 64)); mx = fmaxf(mx, __shfl_xor(mx, 8, 64));
                    const float mn = fmaxf(mrow[m][i], mx);
                    const float al = ex2(mrow[m][i] - mn);
                    mrow[m][i] = mn;
                    float ls = lsum[m][i] * al;
#pragma unroll
                    for (int n = 0; n < 8; ++n) O[m][n][i] *= al;
#pragma unroll
                    for (int n = 0; n < 4; ++n) {
                        const float pv = ex2(s[m][n][i] - mn);
                        ls += pv;
                        pb[m * 1152 + (lq * 4 + i) * 72 + n * 16 + lr] = f2bf(pv);
                    }
                    lsum[m][i] = ls;
                }
            }
            asm volatile("s_waitcnt lgkmcnt(0)" ::: "memory");
#pragma unroll
            for (int ks = 0; ks < 2; ++ks) {
                const bf16x8 p0 = *(const LAS bf16x8*)(pb + lr * 72 + ks * 32 + lq * 8);
                const bf16x8 p1 = *(const LAS bf16x8*)(pb + 1152 + lr * 72 + ks * 32 + lq * 8);
#pragma unroll
                for (int n = 0; n < 8; ++n) {
                    const bf16x8 vf = *(const LAS bf16x8*)(bV + (n * 16 + lr) * 72 + ks * 32 + lq * 8);
                    O[0][n] = MFMA16(p0, vf, O[0][n]);
                    O[1][n] = MFMA16(p1, vf, O[1][n]);
                }
            }
            if (more) {
                LAS u16* nb = sm + (cur ^ 1) * 18432;
                *(LAS bf16x8*)(nb + krow * 72 + kseg) = g0; *(LAS bf16x8*)(nb + 4608 + krow * 72 + kseg) = g1;
                *(LAS bf16x8*)(nb + 9216 + vrow * 72 + vseg) = g2; *(LAS bf16x8*)(nb + 9216 + vrow * 72 + vseg + 8) = g3;
            }
            __syncthreads();
        }
#pragma unroll
        for (int i = 0; i < 4; ++i) {
            float l0 = lsum[0][i], l1 = lsum[1][i];
#pragma unroll
            for (int o = 1; o < 16; o <<= 1) { l0 += __shfl_xor(l0, o, 64); l1 += __shfl_xor(l1, o, 64); }
            const float i0 = 1.0f / l0, i1 = lamv / l1;
            float ov[8]; float ss = 0.f;
#pragma unroll
            for (int n = 0; n < 8; ++n) { ov[n] = O[0][n][i] * i0 - O[1][n][i] * i1; ss += ov[n] * ov[n]; }
#pragma unroll
            for (int o = 1; o < 16; o <<= 1) ss += __shfl_xor(ss, o, 64);
            const float rstd = rsqrtf(ss * (1.0f / 128.0f) + 1e-6f) * (1.0f - lam_init);
            const int r = r0 + w * 16 + lq * 4 + i;
#pragma unroll
            for (int n = 0; n < 8; ++n) {
                const int dv = n * 16 + lr;
                const float zz = bf2f(Z[(size_t)r * 1024 + h * 128 + dv]);
                A[(size_t)r * 1024 + h * 128 + dv] = f2bf(ov[n] * rstd * subln[dv] * zz);
            }
        }
    }
}

__device__ __forceinline__ void phase_ret(const Prm& p, LAS unsigned char* lds) {
    const int tid = tid_l(), w = tid >> 6, lane = tid & 63, lr = lane & 15, lq = lane >> 4;
    LAS u16* RK = (LAS u16*)lds;
    LAS u16* RP = (LAS u16*)lds + w * 2176;
    LAS u16* RV0 = (LAS u16*)lds + 33792;
    LAS u16* RV1 = (LAS u16*)lds + 42496;
    LAS u16* RS = (LAS u16*)lds + 51200;
    const u16* QR = (const u16*)(p.ws + UR_QR); const u16* KR = (const u16*)(p.ws + UR_KR);
    const u16* KTR = (const u16*)(p.ws + UR_KTR); const u16* VTR = (const u16*)(p.ws + UR_VTR);
    u16* OB = (u16*)(p.ws + UR_O); u16* SB = (u16*)(p.ws + UR_SB);
    const int G = gridDim.x;
    const int nlb = (G / 2 < 128) ? G / 2 : 128;
    int first, stride, limit;
    if ((int)blockIdx.x < nlb) { first = blockIdx.x; stride = nlb; limit = 128; }
    else { first = 128 + blockIdx.x - nlb; stride = G - nlb; limit = 640; }
    for (int it = first; it < limit; it += stride) {
        const bool lat = it < 128;
        int b, h, ds, r0, nc;
        if (lat) { b = it >> 5; h = (it >> 3) & 3; ds = it & 7; r0 = 4096 + b * 1024; nc = 8; }
        else { const int i2 = it - 128; b = i2 >> 5; h = (i2 >> 3) & 3; ds = i2 & 7; r0 = b * 256; nc = 2; }
        const float lgf2 = log1pf(-expf(p.in[17][h])) * LOG2E, lgb2 = log1pf(-expf(p.in[18][h])) * LOG2E;
        const float cdf = ex2(128.0f * lgf2), cdb = ex2(128.0f * lgb2);
        u16* slots = lat ? SB + (size_t)it * 8 * 16384 : SB + (size_t)(1024 + it - 128) * 16384;
        const size_t st_off = (size_t)(b * 4 + h) * 131072 + ds * 64;
        const u16* ktw = KTR + (size_t)(h * 256 + w * 32 + lr) * 8192 + r0 + lq * 8;
        f32x4 S[2][4];
#pragma unroll
        for (int mt = 0; mt < 2; ++mt)
#pragma unroll
            for (int nt = 0; nt < 4; ++nt)
#pragma unroll
                for (int i = 0; i < 4; ++i)
                    S[mt][nt][i] = lat ? p.in[5][st_off + (size_t)(w * 32 + mt * 16 + lq * 4 + i) * 512 + nt * 16 + lr] : 0.f;
        if (lat) {
#pragma unroll
            for (int mt = 0; mt < 2; ++mt)
#pragma unroll
                for (int nt = 0; nt < 4; ++nt)
                    *(u32x2*)(slots + (size_t)(nc - 1) * 16384 + (nt * 16 + lr) * 256 + w * 32 + mt * 16 + lq * 4) = pk4(S[mt][nt]);
        }
        for (int c = nc - 1; c >= (lat ? 1 : 0); --c) {
            float lb = lgb2; int tv = tid; asm volatile("" : "+v"(lb), "+v"(tv));
            __syncthreads();
#pragma unroll
            for (int k = 0; k < 2; ++k) {
                const int idx = tv + k * 512, row = idx >> 4, seg = idx & 15;
                const bf16x8 v = *(const bf16x8*)(VTR + (size_t)(h * 512 + ds * 64 + row) * 8192 + r0 + c * 128 + seg * 8);
                bf16x8 o;
#pragma unroll
                for (int q = 0; q < 8; ++q) o[q] = (short)f2bf(bf2f((u16)v[q]) * ex2(lb * (float)(seg * 8 + q)));
                *(LAS bf16x8*)(RV1 + row * 136 + seg * 8) = o;
            }
            __syncthreads();
#pragma unroll
            for (int mt = 0; mt < 2; ++mt)
#pragma unroll
                for (int nt = 0; nt < 4; ++nt) S[mt][nt] = S[mt][nt] * cdb;
#pragma unroll
            for (int ks = 0; ks < 4; ++ks) {
                bf16x8 kf[2];
#pragma unroll
                for (int mt = 0; mt < 2; ++mt) kf[mt] = *(const bf16x8*)(ktw + (size_t)mt * 16 * 8192 + c * 128 + ks * 32);
#pragma unroll
                for (int nt = 0; nt < 4; ++nt) {
                    const bf16x8 vf = *(const LAS bf16x8*)(RV1 + (nt * 16 + lr) * 136 + ks * 32 + lq * 8);
#pragma unroll
                    for (int mt = 0; mt < 2; ++mt) S[mt][nt] = MFMA16(kf[mt], vf, S[mt][nt]);
                }
            }
            if (c >= 1) {
#pragma unroll
                for (int mt = 0; mt < 2; ++mt)
#pragma unroll
                    for (int nt = 0; nt < 4; ++nt)
                        *(u32x2*)(slots + (size_t)(c - 1) * 16384 + (nt * 16 + lr) * 256 + w * 32 + mt * 16 + lq * 4) = pk4(S[mt][nt]);
            }
        }
        if (!lat) {
#pragma unroll
            for (int mt = 0; mt < 2; ++mt)
#pragma unroll
                for (int nt = 0; nt < 4; ++nt)
#pragma unroll
                    for (int i = 0; i < 4; ++i)
                        p.out[OUT_NSB + st_off + (size_t)(w * 32 + mt * 16 + lq * 4 + i) * 512 + nt * 16 + lr] = S[mt][nt][i];
        }
        __threadfence();
#pragma unroll
        for (int mt = 0; mt < 2; ++mt)
#pragma unroll
            for (int nt = 0; nt < 4; ++nt)
#pragma unroll
                for (int i = 0; i < 4; ++i)
                    S[mt][nt][i] = lat ? p.in[4][st_off + (size_t)(w * 32 + mt * 16 + lq * 4 + i) * 512 + nt * 16 + lr] : 0.f;
        for (int c = 0; c < nc; ++c) {
            const bool has_f = lat || c > 0, has_b = lat || c < nc - 1;
            const int rc = r0 + c * 128;
            float lf = lgf2, lb = lgb2; int tv = tid, lqv = lq, lrv = lr; asm volatile("" : "+v"(lf), "+v"(lb), "+v"(tv), "+v"(lqv), "+v"(lrv));
            __syncthreads();
#pragma unroll
            for (int k = 0; k < 8; ++k) {
                const int idx = tid + k * 512, row = idx >> 5, seg = idx & 31;
                *(LAS bf16x8*)(RK + row * 264 + seg * 8) = *(const bf16x8*)(KR + (size_t)(rc + row) * 1024 + h * 256 + seg * 8);
            }
#pragma unroll
            for (int k = 0; k < 2; ++k) {
                const int idx = tv + k * 512, row = idx >> 4, seg = idx & 15;
                const bf16x8 v = *(const bf16x8*)(VTR + (size_t)(h * 512 + ds * 64 + row) * 8192 + rc + seg * 8);
                bf16x8 o;
#pragma unroll
                for (int q = 0; q < 8; ++q) o[q] = (short)f2bf(bf2f((u16)v[q]) * ex2(lf * (float)(127 - seg * 8 - q)));
                *(LAS bf16x8*)(RV0 + row * 136 + seg * 8) = v;
                *(LAS bf16x8*)(RV1 + row * 136 + seg * 8) = o;
            }
            if (has_f) {
#pragma unroll
                for (int mt = 0; mt < 2; ++mt)
#pragma unroll
                    for (int nt = 0; nt < 4; ++nt)
                        *(LAS u32x2*)(RS + (nt * 16 + lr) * 264 + w * 32 + mt * 16 + lq * 4) = pk4(S[mt][nt]);
            }
            bf16x8 qf[8];
#pragma unroll
            for (int ks = 0; ks < 8; ++ks) qf[ks] = *(const bf16x8*)(QR + (size_t)(rc + w * 16 + lr) * 1024 + h * 256 + ks * 32 + lq * 8);
            __syncthreads();
            __builtin_amdgcn_sched_barrier(0);
            f32x4 P[8], O[4];
#pragma unroll
            for (int nt = 0; nt < 8; ++nt) P[nt] = (f32x4){0.f, 0.f, 0.f, 0.f};
#pragma unroll
            for (int nt = 0; nt < 4; ++nt) O[nt] = (f32x4){0.f, 0.f, 0.f, 0.f};
#pragma unroll
            for (int ks = 0; ks < 8; ++ks)
#pragma unroll
                for (int nt = 0; nt < 8; ++nt) {
                    const bf16x8 kf = *(const LAS bf16x8*)(RK + (nt * 16 + lr) * 264 + ks * 32 + lq * 8);
                    P[nt] = MFMA16(qf[ks], kf, P[nt]);
                }
            if (has_f) {
#pragma unroll
                for (int ks = 0; ks < 8; ++ks)
#pragma unroll
                    for (int nt = 0; nt < 4; ++nt) {
                        const bf16x8 sf = *(const LAS bf16x8*)(RS + (nt * 16 + lr) * 264 + ks * 32 + lq * 8);
                        O[nt] = MFMA16(qf[ks], sf, O[nt]);
                    }
#pragma unroll
                for (int i = 0; i < 4; ++i) {
                    const float qd = ex2(lf * (float)(w * 16 + lqv * 4 + i + 1));
#pragma unroll
                    for (int nt = 0; nt < 4; ++nt) O[nt][i] *= qd;
                }
            }
            __syncthreads();
            __builtin_amdgcn_sched_barrier(0);
#pragma unroll
            for (int nt = 0; nt < 8; ++nt)
#pragma unroll
                for (int i = 0; i < 4; ++i) {
                    const int n = w * 16 + lqv * 4 + i, m = nt * 16 + lrv, df = n - m;
                    const float dm = df > 0 ? ex2(lf * (float)df) : (df < 0 ? ex2(lb * (float)(-df)) : 2.0f);
                    RP[(lq * 4 + i) * 136 + nt * 16 + lr] = f2bf(P[nt][i] * dm);
                }
            if (has_b) {
#pragma unroll
                for (int k = 0; k < 4; ++k) {
                    const int idx = tid + k * 512, row = idx >> 5, seg = idx & 31;
                    *(LAS bf16x8*)(RS + row * 264 + seg * 8) = *(const bf16x8*)(slots + (size_t)c * 16384 + row * 256 + seg * 8);
                }
            }
            __syncthreads();
            __builtin_amdgcn_sched_barrier(0);
            if (has_b) {
#pragma unroll
                for (int ks = 0; ks < 8; ++ks) qf[ks] = *(const bf16x8*)(QR + (size_t)(rc + w * 16 + lr) * 1024 + h * 256 + ks * 32 + lq * 8);
                f32x4 Ob[4];
#pragma unroll
                for (int nt = 0; nt < 4; ++nt) Ob[nt] = (f32x4){0.f, 0.f, 0.f, 0.f};
#pragma unroll
                for (int ks = 0; ks < 8; ++ks)
#pragma unroll
                    for (int nt = 0; nt < 4; ++nt) {
                        const bf16x8 sf = *(const LAS bf16x8*)(RS + (nt * 16 + lr) * 264 + ks * 32 + lq * 8);
                        Ob[nt] = MFMA16(qf[ks], sf, Ob[nt]);
                    }
#pragma unroll
                for (int i = 0; i < 4; ++i) {
                    const float qd = ex2(lb * (float)(128 - (w * 16 + lqv * 4 + i)));
#pragma unroll
                    for (int nt = 0; nt < 4; ++nt) O[nt][i] += Ob[nt][i] * qd;
                }
            }
            __builtin_amdgcn_sched_barrier(0);
#pragma unroll
            for (int ks = 0; ks < 4; ++ks) {
                const bf16x8 pf = *(const LAS bf16x8*)(RP + lr * 136 + ks * 32 + lq * 8);
#pragma unroll
                for (int nt = 0; nt < 4; ++nt) {
                    const bf16x8 vf = *(const LAS bf16x8*)(RV0 + (nt * 16 + lr) * 136 + ks * 32 + lq * 8);
                    O[nt] = MFMA16(pf, vf, O[nt]);
                }
            }
            __builtin_amdgcn_sched_barrier(0);
#pragma unroll
            for (int mt = 0; mt < 2; ++mt)
#pragma unroll
                for (int nt = 0; nt < 4; ++nt) S[mt][nt] = S[mt][nt] * cdf;
#pragma unroll
            for (int ks = 0; ks < 4; ++ks) {
                bf16x8 kf[2];
#pragma unroll
                for (int mt = 0; mt < 2; ++mt) kf[mt] = *(const bf16x8*)(ktw + (size_t)mt * 16 * 8192 + c * 128 + ks * 32);
#pragma unroll
                for (int nt = 0; nt < 4; ++nt) {
                    const bf16x8 vf = *(const LAS bf16x8*)(RV1 + (nt * 16 + lr) * 136 + ks * 32 + lq * 8);
#pragma unroll
                    for (int mt = 0; mt < 2; ++mt) S[mt][nt] = MFMA16(kf[mt], vf, S[mt][nt]);
                }
            }
            __builtin_amdgcn_sched_barrier(0);
#pragma unroll
            for (int nt = 0; nt < 4; ++nt)
#pragma unroll
                for (int i = 0; i < 4; ++i)
                    OB[(size_t)(rc + w * 16 + lq * 4 + i) * 2048 + h * 512 + ds * 64 + nt * 16 + lr] = f2bf(O[nt][i]);
        }
        if (!lat) {
#pragma unroll
            for (int mt = 0; mt < 2; ++mt)
#pragma unroll
                for (int nt = 0; nt < 4; ++nt)
#pragma unroll
                    for (int i = 0; i < 4; ++i)
                        p.out[OUT_NSF + st_off + (size_t)(w * 32 + mt * 16 + lq * 4 + i) * 512 + nt * 16 + lr] = S[mt][nt][i];
        }
    }
}

__device__ __forceinline__ void phase_retfin(const Prm& p) {
    const int tid = tid_l(), w = tid >> 6, lane = tid & 63;
    const u16* OB = (const u16*)(p.ws + UR_O); const u16* Gb = (const u16*)(p.ws + UR_G);
    u16* A2 = (u16*)(p.ws + UR_QR);
    for (int rh = blockIdx.x * 8 + w; rh < 8192 * 4; rh += gridDim.x * 8) {
        const size_t off = (size_t)(rh >> 2) * 2048 + (rh & 3) * 512 + lane * 8;
        const bf16x8 o = *(const bf16x8*)(OB + off), g = *(const bf16x8*)(Gb + off);
        float of[8]; float ss = 0.f;
#pragma unroll
        for (int q = 0; q < 8; ++q) { of[q] = bf2f((u16)o[q]); ss += of[q] * of[q]; }
#pragma unroll
        for (int s = 32; s; s >>= 1) ss += __shfl_xor(ss, s, 64);
        const float rstd = rsqrtf(ss * (1.0f / 512.0f) + 1e-6f);
        bf16x8 a;
#pragma unroll
        for (int q = 0; q < 8; ++q) a[q] = (short)f2bf(of[q] * rstd * bf2f((u16)g[q]));
        *(bf16x8*)(A2 + off) = a;
    }
}

__device__ __forceinline__ void phase_convfin(const Prm& p) {
    const u16* T1 = (const u16*)(p.ws + UC_T1); const u16* PC = (const u16*)(p.ws + UC_PC);
    u16* A = (u16*)(p.ws + WS_ABUF);
    const float* cw = p.in[21];
    for (int idx = blockIdx.x * NTHREADS + tid_l(); idx < 8192 * 128; idx += gridDim.x * NTHREADS) {
        const int r = idx >> 7, e = (idx & 127) * 8;
        const int t = r < 4096 ? (r & 255) : (r & 1023), T = r < 4096 ? 256 : 1024;
        const size_t off = (size_t)r * 1024 + e;
        const bf16x8 t1 = *(const bf16x8*)(T1 + off), pc = *(const bf16x8*)(PC + off);
        bf16x8 pp, pn;
#pragma unroll
        for (int q = 0; q < 8; ++q) { pp[q] = 0; pn[q] = 0; }
        if (t > 0) pp = *(const bf16x8*)(PC + off - 1024);
        if (t < T - 1) pn = *(const bf16x8*)(PC + off + 1024);
        bf16x8 a;
#pragma unroll
        for (int q = 0; q < 8; ++q) {
            const float cv = cw[e + q] * bf2f((u16)pp[q]) + cw[1024 + e + q] * bf2f((u16)pc[q]) + cw[2048 + e + q] * bf2f((u16)pn[q]);
            a[q] = (short)f2bf(bf2f((u16)t1[q]) * cv);
        }
        *(bf16x8*)(A + off) = a;
    }
}

__global__ void __launch_bounds__(512) mega(Prm p) {
    extern __shared__ __attribute__((aligned(16))) unsigned char shm[];
    LAS unsigned char* lds = (LAS unsigned char*)shm;
    cg::grid_group grid = cg::this_grid();
    pg8::StaticOrder S;
    phase_p0a(p, lds);
    grid.sync();
    phase_p0b(p);
    cache_convert(p, 0);
    grid.sync();
    for (int li = 0; li < 4; ++li) {
        const int kind = li % 3, j = li / 3;
        {
            pg8::Gemm g; g.A = (const u16*)(p.ws + WS_ABUF); g.M = 8192; g.K = 1024;
            if (kind == 0) { g.Bt = (const u16*)(p.ws + (j == 0 ? WS_WT_A0 : WS_WT_A1)); g.N = 4096; }
            else if (kind == 1) { g.Bt = (const u16*)(p.ws + WS_WT_B); g.N = 6144; }
            else { g.Bt = (const u16*)(p.ws + WS_WT_C); g.N = 4096; }
            Epi E; E.kind = kind; E.layer = li; E.j = j; E.p = &p;
            S.init(g.M, g.N, (int)gridDim.x, (int)blockIdx.x);
            pg8::gemm_phase<Epi, pg8::StaticOrder, false>(lds, g, S, E, nullptr);
        }
        grid.sync();
        if (kind == 0) { phase_attn(p, j, lds); }
        else if (kind == 1) { phase_ret(p, lds); grid.sync(); phase_retfin(p); }
        else { phase_convfin(p); }
        grid.sync();
        {
            pg8::Gemm g; g.M = 8192; g.N = 1024;
            if (kind == 0) { g.A = (const u16*)(p.ws + WS_ABUF); g.Bt = (const u16*)(p.ws + (j == 0 ? WS_WT_OA0 : WS_WT_OA1)); g.K = 1024; }
            else if (kind == 1) { g.A = (const u16*)(p.ws + UR_QR); g.Bt = (const u16*)(p.ws + WS_WT_OB); g.K = 2048; }
            else { g.A = (const u16*)(p.ws + WS_ABUF); g.Bt = (const u16*)(p.ws + WS_WT_OC); g.K = 1024; }
            Epi E; E.kind = 3; E.layer = li; E.j = j; E.p = &p;
            S.init(g.M, g.N, (int)gridDim.x, (int)blockIdx.x);
            pg8::gemm_phase<Epi, pg8::StaticOrder, false>(lds, g, S, E, nullptr);
        }
        grid.sync();
        phase_ln(p, li, li + 1);
        if (li == 2) cache_convert(p, 1);
        grid.sync();
    }
}

extern "C" void kernel_launch(void* const* d_in, const int* in_sizes, int n_in, void* d_out, int out_size, void* d_ws, size_t ws_size, hipStream_t stream) {
    static int grid_blocks = 0;
    if (!grid_blocks) {
        int dev = 0, cus = 0, per_cu = 0;
        hipGetDevice(&dev);
        hipDeviceGetAttribute(&cus, hipDeviceAttributeMultiprocessorCount, dev);
        hipFuncSetAttribute((const void*)mega, hipFuncAttributeMaxDynamicSharedMemorySize, LDS_BYTES);
        hipOccupancyMaxActiveBlocksPerMultiprocessor(&per_cu, mega, NTHREADS, LDS_BYTES);
        if (per_cu < 1) per_cu = 1;
        if (per_cu > 1) per_cu = 1;
        grid_blocks = cus * per_cu;
        if (ws_size < WS_NEEDED) fprintf(stderr, "workspace too small: %zu < %zu\n", ws_size, (size_t)WS_NEEDED);
    }
    Prm p{};
    for (int i = 0; i < 23; ++i) p.in[i] = (const float*)d_in[i];
    p.out = (float*)d_out;
    p.ws = (char*)d_ws;
    p.lam_init[0] = (float)(0.8 - 0.6 * exp(-0.3 * 0.0));
    p.lam_init[1] = (float)(0.8 - 0.6 * exp(-0.3 * 3.0));
    void* args[] = {&p};
    hipError_t e = hipLaunchCooperativeKernel((void*)mega, dim3(grid_blocks), dim3(NTHREADS), args, LDS_BYTES, stream);
    if (e != hipSuccess) fprintf(stderr, "cooperative launch failed: %s (grid %d)\n", hipGetErrorString(e), grid_blocks);
}
```

```cpp
#include <hip/hip_runtime.h>
#include <hip/hip_cooperative_groups.h>
#include <cstdio>
#include <cmath>
namespace cg = cooperative_groups;

namespace pg8 {
#define PG8_LAS __attribute__((address_space(3)))
typedef unsigned short bf16_t;
typedef short bf16x8 __attribute__((ext_vector_type(8)));
typedef float f32x4 __attribute__((ext_vector_type(4)));
typedef unsigned u32x4 __attribute__((ext_vector_type(4)));
constexpr int BM = 256, BK = 64, HALF = 128, HTB = HALF * BK * 2  , STAGE_BYTES = 8 * HTB, NXCD = 8, WGM = 8;
__host__ __device__ __forceinline__ int lds_byte(int r, int c) { const int st = (r >> 4) * 2 + (c >> 5), rr = r & 15, cc = c & 31, ob = rr * 64 + cc * 2; return st * 1024 + (ob ^ (((ob >> 9) & 1) << 5)); }
__host__ __device__ __forceinline__ void stage_rc(int b, int& R, int& C) { const int st = b / 1024, sb = b % 1024, swz = sb ^ (((sb >> 9) & 1) << 5); R = (st >> 1) * 16 + swz / 64; C = (st & 1) * 32 + (swz % 64) / 2; }
__host__ __device__ __forceinline__ int perm32(int rho) { const int n = rho >> 4, i = rho & 15; return 8 * (i >> 2) + 4 * n + (i & 3); }

struct Unit { int pm, pn; };
struct Gemm { const bf16_t* A; const bf16_t* Bt; int M, N, K; };

struct StaticOrder {
    int nM, nN, nwg, G, c;
    __host__ __device__ void init(int M, int N, int G_, int c_) { nM = M / BM; nN = N / BM; nwg = nM * nN; G = G_; c = c_; }
    __host__ __device__ bool next(int i, Unit& u) const {
        const long L = (long)i * G + c; if (L >= nwg) return false;
        int wgid = (int)L; { const int q = nwg / NXCD, r = nwg % NXCD, xcd = wgid % NXCD, off = wgid / NXCD; wgid = (xcd < r ? xcd * (q + 1) : r * (q + 1) + (xcd - r) * q) + off; }
        const int nig = WGM * nN, gid = wgid / nig, fm = gid * WGM, gsz = (nM - fm) < WGM ? (nM - fm) : WGM;
        u.pm = fm + ((wgid % nig) % gsz); u.pn = (wgid % nig) / gsz; return true;
    }
    __device__ __forceinline__ void a_ready(const Unit&) const {}
    __device__ __forceinline__ void done(const Unit&) const {}
};
template <class Epi, class Sched, bool STAMP = false>
__device__ __forceinline__ void gemm_phase(PG8_LAS unsigned char* lds, const Gemm g, const Sched& S, const Epi& E, unsigned long long* stamps) {
    int tid_ = threadIdx.x; asm volatile("" : "+v"(tid_)); const int tid = tid_, wid = __builtin_amdgcn_readfirstlane(tid >> 6), lane = tid & 63, wr = wid >> 2, wc = wid & 3, fr = lane & 15, fq = lane >> 4;
    const int K = g.K, nt = K / BK;
    int ts_lo = 0, ts_hi = 0, nts = 0; const unsigned long long rt_entry = STAMP ? (unsigned long long)wall_clock64() : 0ull;
#define PG8_STAMP() do { if (STAMP && wid == 0 && nts < 64) { const unsigned long long _c = (unsigned long long)clock64(); \
        ts_lo = (lane == nts) ? (int)(unsigned)_c : ts_lo; ts_hi = (lane == nts) ? (int)(unsigned)(_c >> 32) : ts_hi; ++nts; } } while (0)
    PG8_STAMP();
    unsigned voffA[2], voffB[2];
#pragma unroll
    for (int i = 0; i < 2; ++i) { int R, C; stage_rc(tid * 16 + i * 8192, R, C); const int Rb = Epi::PERM ? ((R & ~31) + perm32(R & 31)) : R;
        voffA[i] = (unsigned)(R * K + C) * 2u; voffB[i] = (unsigned)(Rb * K + C) * 2u; }
    const size_t kstep = (size_t)(BK * 2);
    const size_t hstep = (size_t)HALF * K * 2;
    const size_t tstep = 2 * hstep;
    const unsigned ldsw = (unsigned)wid * 1024u;
    const int aoff = lds_byte(wr * 64 + fr, fq * 8), boff = lds_byte(wc * 32 + fr, fq * 8);
#define PG8_SA(b, h) (((b) * 2 + (h)) * HTB)
#define PG8_SB(b, h) ((4 + (b) * 2 + (h)) * HTB)
#define PG8_STAGE(bufoff, gbase, voff) do { _Pragma("unroll") for (int _i = 0; _i < 2; ++_i) \
        __builtin_amdgcn_global_load_lds((const unsigned*)((const char*)(gbase) + (voff)[_i]), (PG8_LAS unsigned*)(lds + (bufoff) + ldsw + _i * 8192), 16, 0, 0); } while (0)
#define PG8_LDA(dst, b, h) do { _Pragma("unroll") for (int m = 0; m < 4; ++m) _Pragma("unroll") for (int k = 0; k < 2; ++k) dst[m][k] = *(const PG8_LAS bf16x8*)(lds + PG8_SA(b, h) + aoff + m * 2048 + k * 1024); } while (0)
#define PG8_LDB(dst, b, h) do { _Pragma("unroll") for (int n = 0; n < 2; ++n) _Pragma("unroll") for (int k = 0; k < 2; ++k) dst[n][k] = *(const PG8_LAS bf16x8*)(lds + PG8_SB(b, h) + boff + n * 2048 + k * 1024); } while (0)
#define PG8_MMA(ai, bj, At, Bt) do { __builtin_amdgcn_s_setprio(1); _Pragma("unroll") for (int m = 0; m < 4; ++m) _Pragma("unroll") for (int n = 0; n < 2; ++n) _Pragma("unroll") for (int k = 0; k < 2; ++k) \
        acc[ai][bj][m][n] = __builtin_amdgcn_mfma_f32_16x16x32_bf16(Bt[n][k], At[m][k], acc[ai][bj][m][n], 0, 0, 0); __builtin_amdgcn_s_setprio(0); } while (0)
#define PG8_WAIT_V(n) asm volatile("s_waitcnt vmcnt(" #n ")" ::: "memory")
#define PG8_WAIT_L(n) asm volatile("s_waitcnt lgkmcnt(" #n ")" ::: "memory")
#define PG8_BAR __builtin_amdgcn_s_barrier()
#define PG8_SCHED __builtin_amdgcn_sched_barrier(0)
    Unit cur, nxt; int ui = 0;
    if (!S.next(0, cur)) return;
    f32x4 acc[2][2][4][2];
#pragma unroll
    for (int a = 0; a < 2; ++a)
#pragma unroll
        for (int b = 0; b < 2; ++b)
#pragma unroll
            for (int m = 0; m < 4; ++m)
#pragma unroll
                for (int n = 0; n < 2; ++n) acc[a][b][m][n] = (f32x4){0.f, 0.f, 0.f, 0.f};
    bf16x8 At[4][2], B0[2][2], B1[2][2];
    const char* cA = (const char*)g.A + (size_t)cur.pm * tstep; const char* cB = (const char*)g.Bt + (size_t)cur.pn * tstep;
    S.a_ready(cur);
    PG8_STAGE(PG8_SB(0, 0), cB, voffB); PG8_STAGE(PG8_SA(0, 0), cA, voffA); PG8_STAGE(PG8_SB(0, 1), cB + hstep, voffB); PG8_STAGE(PG8_SA(0, 1), cA + hstep, voffA);
    if (wr == 1) PG8_BAR;
    PG8_WAIT_V(4); PG8_BAR;
    PG8_STAGE(PG8_SB(1, 0), cB + kstep, voffB); PG8_STAGE(PG8_SA(1, 0), cA + kstep, voffA); PG8_STAGE(PG8_SB(1, 1), cB + hstep + kstep, voffB);
    PG8_WAIT_V(6); PG8_BAR;
    PG8_STAMP();
    for (;;) {
        const bool has_next = S.next(ui + 1, nxt);
        const char* nA = has_next ? (const char*)g.A + (size_t)nxt.pm * tstep : cA; const char* nB = has_next ? (const char*)g.Bt + (size_t)nxt.pn * tstep : cB;
        for (int t = 0; t < nt; t += 2) {
            const bool last = (t == nt - 2);
            const char* a1 = cA + (size_t)(t + 1) * kstep;
            const char* a2 = last ? nA : cA + (size_t)(t + 2) * kstep; const char* b2 = last ? nB : cB + (size_t)(t + 2) * kstep;
            const char* a3 = a2 + kstep; const char* b3 = b2 + kstep;
            if (last && has_next) S.a_ready(nxt);
            PG8_LDB(B0, 0, 0); PG8_SCHED; PG8_LDA(At, 0, 0); PG8_STAGE(PG8_SA(1, 1), a1 + hstep, voffA);
            PG8_WAIT_L(8); PG8_BAR; PG8_WAIT_L(0); PG8_MMA(0, 0, At, B0); PG8_BAR; PG8_SCHED;
            PG8_LDB(B1, 0, 1); PG8_STAGE(PG8_SB(0, 0), b2, voffB);
            PG8_BAR; PG8_WAIT_L(0); PG8_MMA(0, 1, At, B1); PG8_BAR;
            PG8_LDA(At, 0, 1); PG8_STAGE(PG8_SA(0, 0), a2, voffA);
            PG8_BAR; PG8_WAIT_L(0); PG8_MMA(1, 0, At, B0); PG8_BAR; PG8_SCHED;
            PG8_STAGE(PG8_SB(0, 1), b2 + hstep, voffB);
            PG8_WAIT_V(6); PG8_BAR; PG8_MMA(1, 1, At, B1); PG8_BAR;
            PG8_LDB(B0, 1, 0); PG8_SCHED; PG8_LDA(At, 1, 0); PG8_STAGE(PG8_SA(0, 1), a2 + hstep, voffA);
            PG8_WAIT_L(8); PG8_BAR; PG8_WAIT_L(0); PG8_MMA(0, 0, At, B0); PG8_BAR; PG8_SCHED;
            PG8_LDB(B1, 1, 1); PG8_STAGE(PG8_SB(1, 0), b3, voffB);
            PG8_BAR; PG8_WAIT_L(0); PG8_MMA(0, 1, At, B1); PG8_BAR;
            PG8_LDA(At, 1, 1); PG8_STAGE(PG8_SA(1, 0), a3, voffA);
            PG8_BAR; PG8_WAIT_L(0); PG8_MMA(1, 0, At, B0); PG8_BAR; PG8_SCHED;
            PG8_STAGE(PG8_SB(1, 1), b3 + hstep, voffB);
            PG8_WAIT_V(6); PG8_BAR; PG8_MMA(1, 1, At, B1); PG8_BAR;
        }
        PG8_STAMP();
        if constexpr (!Epi::AFTER_DRAIN) { E(acc, cur, wr, wc, fr, fq); S.done(cur); }
        PG8_STAMP();
        if (!has_next) break;
#pragma unroll
        for (int a = 0; a < 2; ++a)
#pragma unroll
            for (int b = 0; b < 2; ++b)
#pragma unroll
                for (int m = 0; m < 4; ++m)
#pragma unroll
                    for (int n = 0; n < 2; ++n) acc[a][b][m][n] = (f32x4){0.f, 0.f, 0.f, 0.f};
        cur = nxt; cA = nA; cB = nB; ++ui;
    }
    PG8_WAIT_V(0);
    if (wr == 0) PG8_BAR;
    PG8_BAR;
    if constexpr (Epi::AFTER_DRAIN) { E.fused(acc, cur, wr, wc, fr, fq, lds, wid, lane); S.done(cur); }
    PG8_STAMP();
    if (STAMP && wid == 0) { stamps[lane] = lane < nts ? (((unsigned long long)(unsigned)ts_hi << 32) | (unsigned)ts_lo) : 0ull;
        if (lane == 62) stamps[62] = rt_entry; if (lane == 63) stamps[63] = (unsigned long long)wall_clock64(); }
#undef PG8_STAMP
#undef PG8_SA
#undef PG8_SB
#undef PG8_STAGE
#undef PG8_LDA
#undef PG8_LDB
#undef PG8_MMA
#undef PG8_WAIT_V
#undef PG8_WAIT_L
#undef PG8_BAR
#undef PG8_SCHED
}
}

using pg8::bf16x8; using pg8::f32x4;
typedef unsigned short u16;
typedef unsigned u32x2 __attribute__((ext_vector_type(2)));
#define LAS __attribute__((address_space(3)))

constexpr int NTHREADS = 512;
constexpr int LDS_MAIN = 136192;
constexpr int LDS_BYTES = LDS_MAIN + 16;
constexpr float LOG2E = 1.4426950408889634f;
constexpr float ALPHA_F = 1.681792830507429f;

constexpr size_t OUT_NCK = 8388608, OUT_NCV = 16777216, OUT_NSF = 25165824, OUT_NSB = 33554432;
constexpr size_t WS_WT_A1 = 0, WS_WT_OA1 = 8388608, WS_WT_B = 10485760, WS_WT_OB = 23068672, WS_WT_C = 27262976, WS_WT_OC = 35651584,
                 WS_MOD = 37748736, WS_ROPE = 38010880, WS_ABUF = 38273024, WS_WT_A0 = 55050240, WS_WT_OA0 = 63438848, WS_UATT = 65536000;
constexpr size_t UA_Q = WS_UATT, UA_Z = WS_UATT + 16777216, UA_KC = WS_UATT + 33554432, UA_KL = WS_UATT + 41943040, UA_VTC = WS_UATT + 52428800, UA_VTL = WS_UATT + 60817408;
constexpr size_t UR_QR = WS_WT_A0, UR_KR = UR_QR + 16777216, UR_KTR = UR_QR + 33554432, UR_VTR = UR_QR + 50331648, UR_G = UR_QR + 83886080, UR_O = UR_QR + 117440512, UR_SB = UR_QR + 150994944;
constexpr size_t UC_T1 = WS_UATT, UC_PC = WS_UATT + 16777216;
constexpr size_t WS_BAR = UR_SB + 50331648;
constexpr size_t WS_NEEDED = WS_BAR + 16384;

struct Prm {
    const float* in[23];
    float* out;
    char* ws;
    float lam_init[2];
};

typedef const __attribute__((address_space(4))) Prm* KP;
__device__ __forceinline__ KP lp(KP k) { asm volatile("" : "+s"(k)); return k; }
__device__ __forceinline__ u16 f2bf(float f) { unsigned u = __float_as_uint(f); u += 0x7fffu + ((u >> 16) & 1u); return (u16)(u >> 16); }
__device__ __forceinline__ float bf2f(u16 h) { return __uint_as_float(((unsigned)h) << 16); }
__device__ __forceinline__ unsigned pk2(float lo, float hi) { return (unsigned)f2bf(lo) | ((unsigned)f2bf(hi) << 16); }
__device__ __forceinline__ u32x2 pk4(f32x4 v) { u32x2 r; r.x = pk2(v[0], v[1]); r.y = pk2(v[2], v[3]); return r; }
__device__ __forceinline__ float silu_f(float x) { return x / (1.0f + __expf(-x)); }
__device__ __forceinline__ float ex2(float x) { return __builtin_amdgcn_exp2f(x); }
__device__ __forceinline__ int tid_l() { int t = threadIdx.x; asm volatile("" : "+v"(t)); return t; }
__device__ __forceinline__ int row_n5(int r) { return r < 4096 ? 0 : 1 + ((r - 4096) >> 10); }
#define MFMA16(a, b, c) __builtin_amdgcn_mfma_f32_16x16x32_bf16((a), (b), (c), 0, 0, 0)


#define XB_TMO      128
#define XB_XCNT(j)  (256  + 64 * (j))
#define XB_XSUB(j)  (1280 + 64 * (j))
#define XB_XGEN(j)  (2304 + 64 * (j))
#define XB_TOP      3328
#define XB_TOPGEN   3392
#define XCD_BAR_WORDS 3456
#define XB_SPIN_CAP (1u << 18)
__device__ __forceinline__ unsigned xb_ld(unsigned* p)              { return __hip_atomic_load(p, __ATOMIC_RELAXED, __HIP_MEMORY_SCOPE_AGENT); }
__device__ __forceinline__ unsigned xb_add(unsigned* p, unsigned v) { return __hip_atomic_fetch_add(p, v, __ATOMIC_RELAXED, __HIP_MEMORY_SCOPE_AGENT); }
__device__ __forceinline__ unsigned xb_xcc_id() { return (unsigned)__builtin_amdgcn_s_getreg((3 << 11) | 20) & 0xFu; }
#define XB_SPIN(cond, bar) do { unsigned _sp = 0; while (cond) { __builtin_amdgcn_s_sleep(1); \
    if ((++_sp & 255u) == 0u) { if (xb_ld(&(bar)[XB_TMO])) break; if (_sp > XB_SPIN_CAP) { atomicAdd(&(bar)[XB_TMO], 1u); break; } } } } while (0)
struct XcdBarrier { unsigned* bar; unsigned x; volatile LAS unsigned* st; };
__device__ __forceinline__ XcdBarrier xcd_barrier_post(unsigned* bar, volatile LAS unsigned* st) {
    XcdBarrier b; b.bar = bar; b.x = xb_xcc_id(); b.st = st;
    if (threadIdx.x == 0) (void)xb_add(&bar[XB_XCNT(b.x)], 1u);
    return b;
}
__device__ __forceinline__ void xcd_barrier_complete(unsigned* bar, unsigned x, unsigned& nloc, unsigned& nx) {
    const unsigned G = gridDim.x * gridDim.y * gridDim.z;
    unsigned sum, cnt, mine, sp = 0u;
    for (;;) {
        sum = 0u; cnt = 0u; mine = 0u;
#pragma unroll
        for (unsigned j = 0; j < 16; ++j) { const unsigned c = xb_ld(&bar[XB_XCNT(j)]); sum += c; cnt += (c > 0u) ? 1u : 0u; mine = (j == x) ? c : mine; }
        if (sum == G) break;
        __builtin_amdgcn_s_sleep(1);
        if ((++sp & 255u) == 0u) { if (xb_ld(&bar[XB_TMO])) break; if (sp > XB_SPIN_CAP) { atomicAdd(&bar[XB_TMO], 1u); break; } }
    }
    nloc = mine > 0u ? mine : 1u; nx = cnt > 0u ? cnt : 1u;
}
__device__ __forceinline__ void xcd_barrier(const XcdBarrier& b) {
    asm volatile("s_waitcnt vmcnt(0)" ::: "memory");
    __syncthreads();
    if (threadIdx.x == 0) {
        unsigned* bar = b.bar;
        __builtin_amdgcn_s_waitcnt(0);
        unsigned nloc = b.st[0], nx = b.st[1];
        if (nloc == 0u) { xcd_barrier_complete(bar, b.x, nloc, nx); b.st[0] = nloc; b.st[1] = nx; }
        const unsigned old = xb_add(&bar[XB_XSUB(b.x)], 1u);
        const unsigned gen = old / nloc;
        if (old + 1u == (gen + 1u) * nloc) {
            __builtin_amdgcn_fence(__ATOMIC_RELEASE, "agent");
            asm volatile("s_waitcnt vmcnt(0)" ::: "memory");
            const unsigned og = xb_add(&bar[XB_TOP], 1u);
            const unsigned tg = og / nx;
            if (og + 1u == (tg + 1u) * nx) xb_add(&bar[XB_TOPGEN], 1u);
            else XB_SPIN(xb_ld(&bar[XB_TOPGEN]) == tg, bar);
            __builtin_amdgcn_fence(__ATOMIC_ACQUIRE, "agent");
            xb_add(&bar[XB_XGEN(b.x)], 1u);
            asm volatile("s_waitcnt vmcnt(0)" ::: "memory");
        } else {
            XB_SPIN(xb_ld(&bar[XB_XGEN(b.x)]) == gen, bar);
            __builtin_amdgcn_fence(__ATOMIC_ACQUIRE, "agent");
            asm volatile("s_waitcnt vmcnt(0)" ::: "memory");
        }
    }
    __syncthreads();
}

struct Epi {
    static constexpr bool PERM = false, AFTER_DRAIN = false;
    int kind; int layer; int j;
    KP p;
    __device__ __forceinline__ void operator()(const f32x4 (&acc)[2][2][4][2], const pg8::Unit& u, int wr, int wc, int fr, int fq) const {
        char* ws = p->ws;
        const int pm = u.pm, pn = u.pn;
        if (kind == 0) {
            const bool lat = pm >= 16;
            const int b = lat ? ((pm - 16) >> 2) : pm;
            const int t0 = lat ? (((pm - 16) & 3) << 8) : 0;
            if (pn < 8) {
                const bool isq = pn < 4;
                const int G = ((pn & 3) << 2) + wc, h = G >> 1, mm = G & 1;
                const float* rope = (const float*)(ws + WS_ROPE);
#pragma unroll
                for (int ai = 0; ai < 2; ++ai)
#pragma unroll
                    for (int m = 0; m < 4; ++m) {
                        const int rl = ai * 128 + wr * 64 + m * 16 + fr;
                        const int r = pm * 256 + rl, t = t0 + rl;
#pragma unroll
                        for (int n = 0; n < 2; ++n) {
                            const int dd = 16 * n + 4 * fq;
                            f32x4 x1 = acc[ai][0][m][n], x2 = acc[ai][1][m][n], o1, o2;
                            if (lat) {
                                const f32x4 cs0 = *(const f32x4*)(rope + ((size_t)t * 32 + dd) * 2), cs1 = *(const f32x4*)(rope + ((size_t)t * 32 + dd) * 2 + 4);
                                const float c0 = cs0[0], s0 = cs0[1], c1 = cs0[2], s1 = cs0[3], c2 = cs1[0], s2 = cs1[1], c3 = cs1[2], s3 = cs1[3];
                                o1[0] = x1[0] * c0 - x2[0] * s0; o2[0] = x1[0] * s0 + x2[0] * c0;
                                o1[1] = x1[1] * c1 - x2[1] * s1; o2[1] = x1[1] * s1 + x2[1] * c1;
                                o1[2] = x1[2] * c2 - x2[2] * s2; o2[2] = x1[2] * s2 + x2[2] * c2;
                                o1[3] = x1[3] * c3 - x2[3] * s3; o2[3] = x1[3] * s3 + x2[3] * c3;
                            } else { o1 = x1; o2 = x2; }
                            if (isq) {
                                u16* q = (u16*)(ws + UA_Q) + (size_t)r * 1024 + G * 64 + dd;
                                *(u32x2*)q = pk4(o1); *(u32x2*)(q + 32) = pk4(o2);
                            } else if (lat) {
                                u16* k = (u16*)(ws + UA_KL) + ((size_t)((b * 8 + h) * 2 + mm) * 1280 + t) * 64 + dd;
                                *(u32x2*)k = pk4(o1); *(u32x2*)(k + 32) = pk4(o2);
                            } else {
                                u16* k = (u16*)(ws + UA_KC) + ((size_t)((b * 8 + h) * 2 + mm) * 256 + t) * 64 + dd;
                                *(u32x2*)k = pk4(o1); *(u32x2*)(k + 32) = pk4(o2);
                                float* o = p->out + OUT_NCK + ((size_t)(b * 2 + j) * 256 + t) * 1024 + G * 64 + dd;
                                *(f32x4*)o = o1; *(f32x4*)(o + 32) = o2;
                            }
                        }
                    }
            } else if (pn < 12) {
#pragma unroll
                for (int ai = 0; ai < 2; ++ai)
#pragma unroll
                    for (int m = 0; m < 4; ++m) {
                        const int rl = ai * 128 + wr * 64 + m * 16 + fr;
                        const int t = t0 + rl;
#pragma unroll
                        for (int bj = 0; bj < 2; ++bj)
#pragma unroll
                            for (int n = 0; n < 2; ++n) {
                                const int c = (pn - 8) * 256 + bj * 128 + wc * 32 + n * 16 + 4 * fq;
                                const int h = c >> 7, dv = c & 127;
                                const f32x4 v = acc[ai][bj][m][n];
                                if (lat) {
                                    u16* vt = (u16*)(ws + UA_VTL) + ((size_t)(b * 8 + h) * 128 + dv) * 1280 + t;
                                    vt[0] = f2bf(v[0]); vt[1280] = f2bf(v[1]); vt[2560] = f2bf(v[2]); vt[3840] = f2bf(v[3]);
                                } else {
                                    u16* vt = (u16*)(ws + UA_VTC) + ((size_t)(b * 8 + h) * 128 + dv) * 256 + t;
                                    vt[0] = f2bf(v[0]); vt[256] = f2bf(v[1]); vt[512] = f2bf(v[2]); vt[768] = f2bf(v[3]);
                                    *(f32x4*)(p->out + OUT_NCV + ((size_t)(b * 2 + j) * 256 + t) * 1024 + c) = v;
                                }
                            }
                    }
            } else {
#pragma unroll
                for (int ai = 0; ai < 2; ++ai)
#pragma unroll
                    for (int m = 0; m < 4; ++m) {
                        const int r = pm * 256 + ai * 128 + wr * 64 + m * 16 + fr;
#pragma unroll
                        for (int bj = 0; bj < 2; ++bj)
#pragma unroll
                            for (int n = 0; n < 2; ++n) {
                                const int c = (pn - 12) * 256 + bj * 128 + wc * 32 + n * 16 + 4 * fq;
                                f32x4 v = acc[ai][bj][m][n];
                                v[0] = silu_f(v[0]); v[1] = silu_f(v[1]); v[2] = silu_f(v[2]); v[3] = silu_f(v[3]);
                                *(u32x2*)((u16*)(ws + UA_Z) + (size_t)r * 1024 + c) = pk4(v);
                            }
                    }
            }
        } else if (kind == 1) {
#pragma unroll
            for (int ai = 0; ai < 2; ++ai)
#pragma unroll
                for (int m = 0; m < 4; ++m) {
                    const int r = pm * 256 + ai * 128 + wr * 64 + m * 16 + fr;
#pragma unroll
                    for (int bj = 0; bj < 2; ++bj)
#pragma unroll
                        for (int n = 0; n < 2; ++n) {
                            const int cb = bj * 128 + wc * 32 + n * 16 + 4 * fq;
                            f32x4 v = acc[ai][bj][m][n];
                            if (pn < 4) {
                                *(u32x2*)((u16*)(ws + UR_QR) + (size_t)r * 1024 + pn * 256 + cb) = pk4(v);
                            } else if (pn < 8) {
                                const int c = (pn - 4) * 256 + cb;
                                v = v * 0.0625f;
                                *(u32x2*)((u16*)(ws + UR_KR) + (size_t)r * 1024 + c) = pk4(v);
                                u16* kt = (u16*)(ws + UR_KTR) + (size_t)c * 8192 + r;
                                kt[0] = f2bf(v[0]); kt[8192] = f2bf(v[1]); kt[16384] = f2bf(v[2]); kt[24576] = f2bf(v[3]);
                            } else if (pn < 16) {
                                const int c = (pn - 8) * 256 + cb;
                                u16* vt = (u16*)(ws + UR_VTR) + (size_t)c * 8192 + r;
                                vt[0] = f2bf(v[0]); vt[8192] = f2bf(v[1]); vt[16384] = f2bf(v[2]); vt[24576] = f2bf(v[3]);
                            } else {
                                const int c = (pn - 16) * 256 + cb;
                                v[0] = silu_f(v[0]); v[1] = silu_f(v[1]); v[2] = silu_f(v[2]); v[3] = silu_f(v[3]);
                                *(u32x2*)((u16*)(ws + UR_G) + (size_t)r * 2048 + c) = pk4(v);
                            }
                        }
                }
        } else if (kind == 2) {
#pragma unroll
            for (int ai = 0; ai < 2; ++ai)
#pragma unroll
                for (int m = 0; m < 4; ++m) {
                    const int r = pm * 256 + ai * 128 + wr * 64 + m * 16 + fr;
                    const int e = pn * 64 + wc * 16 + 4 * fq;
                    const f32x4 bg = acc[ai][0][m][0], cgv = acc[ai][0][m][1], uu = acc[ai][1][m][0], z = acc[ai][1][m][1];
                    f32x4 t1, pc;
#pragma unroll
                    for (int q = 0; q < 4; ++q) { t1[q] = bg[q] * silu_f(z[q]); pc[q] = cgv[q] * uu[q]; }
                    *(u32x2*)((u16*)(ws + UC_T1) + (size_t)r * 1024 + e) = pk4(t1);
                    *(u32x2*)((u16*)(ws + UC_PC) + (size_t)r * 1024 + e) = pk4(pc);
                }
        } else {
            const float* xin = (layer == 0) ? (pm < 16 ? p->in[0] : p->in[1] - (size_t)4096 * 1024) : p->out;
            const float* gate = (const float*)(ws + WS_MOD) + ((size_t)layer * 5 + (pm < 16 ? 0 : 1 + ((pm - 16) >> 2))) * 3072 + 2048;
#pragma unroll
            for (int ai = 0; ai < 2; ++ai)
#pragma unroll
                for (int m = 0; m < 4; ++m) {
                    const int r = pm * 256 + ai * 128 + wr * 64 + m * 16 + fr;
#pragma unroll
                    for (int bj = 0; bj < 2; ++bj)
#pragma unroll
                        for (int n = 0; n < 2; ++n) {
                            const int c = pn * 256 + bj * 128 + wc * 32 + n * 16 + 4 * fq;
                            const f32x4 xv = *(const f32x4*)(xin + (size_t)r * 1024 + c);
                            const f32x4 gv = *(const f32x4*)(gate + c);
                            *(f32x4*)(p->out + (size_t)r * 1024 + c) = xv * ALPHA_F + gv * acc[ai][bj][m][n];
                        }
                }
        }
    }
};

__device__ __forceinline__ int perm_col(int kind, int n) {
    if (kind == 1) {
        if (n >= 2048) return n;
        const int blk = n >> 8, w = n & 255, Gl = w >> 6, half = (w >> 5) & 1, dd = w & 31;
        return (blk << 8) + half * 128 + Gl * 32 + dd;
    } else if (kind == 2) {
        const int part = n >> 10, e = n & 1023, blk = e >> 6, el = e & 63, wc = el >> 4, f = el & 15;
        return blk * 256 + (part >> 1) * 128 + wc * 32 + (part & 1) * 16 + f;
    }
    return n;
}

__device__ __forceinline__ void phase_p0a(KP p, LAS unsigned char* lds) {
    const int tid = tid_l();
    LAS u16* sT = (LAS u16*)lds;
    LAS float* scond = (LAS float*)(lds + 36864);
    LAS float* red = (LAS float*)(lds + 36864 + 20480);
    for (int i = tid; i < 5120; i += NTHREADS) {
        const int n = i >> 10, k = i & 1023;
        const float v = (n == 0) ? p->in[7][k] : p->in[6][(n - 1) * 1024 + k];
        scond[i] = silu_f(v);
    }
    __syncthreads();
    for (int u = blockIdx.x; u < 192; u += gridDim.x) {
        const int i = u / 48, c0 = (u % 48) * 64;
        const int cg4 = (tid & 15) * 4, ks = tid >> 4;
        const float* w = p->in[8] + (size_t)i * 1024 * 3072 + (size_t)(ks * 32) * 3072 + c0 + cg4;
        f32x4 a0 = {0.f, 0.f, 0.f, 0.f}, a1 = a0, a2 = a0, a3 = a0, a4 = a0;
#pragma unroll 8
        for (int k = 0; k < 32; ++k) {
            const f32x4 wv = *(const f32x4*)(w + (size_t)k * 3072);
            const int kk = ks * 32 + k;
            a0 += wv * scond[kk]; a1 += wv * scond[1024 + kk]; a2 += wv * scond[2048 + kk]; a3 += wv * scond[3072 + kk]; a4 += wv * scond[4096 + kk];
        }
        *(LAS f32x4*)(red + (ks * 5 + 0) * 64 + cg4) = a0; *(LAS f32x4*)(red + (ks * 5 + 1) * 64 + cg4) = a1; *(LAS f32x4*)(red + (ks * 5 + 2) * 64 + cg4) = a2;
        *(LAS f32x4*)(red + (ks * 5 + 3) * 64 + cg4) = a3; *(LAS f32x4*)(red + (ks * 5 + 4) * 64 + cg4) = a4;
        __syncthreads();
        if (tid < 320) {
            const int n = tid >> 6, cc = tid & 63;
            float sacc = p->in[9][i * 3072 + c0 + cc];
#pragma unroll
            for (int q = 0; q < 32; ++q) sacc += red[(q * 5 + n) * 64 + cc];
            ((float*)(p->ws + WS_MOD))[((size_t)i * 5 + n) * 3072 + c0 + cc] = sacc;
        }
        __syncthreads();
    }
    for (int mi = 0; mi < 8; ++mi) {
        const float* W; size_t off; int K, N, kind;
        switch (mi) {
            case 0: W = p->in[12]; off = WS_WT_A0; K = 1024; N = 4096; kind = 1; break;
            case 1: W = p->in[12] + (size_t)1024 * 4096; off = WS_WT_A1; K = 1024; N = 4096; kind = 1; break;
            case 2: W = p->in[15]; off = WS_WT_OA0; K = 1024; N = 1024; kind = 0; break;
            case 3: W = p->in[15] + (size_t)1024 * 1024; off = WS_WT_OA1; K = 1024; N = 1024; kind = 0; break;
            case 4: W = p->in[16]; off = WS_WT_B; K = 1024; N = 6144; kind = 0; break;
            case 5: W = p->in[19]; off = WS_WT_OB; K = 2048; N = 1024; kind = 0; break;
            case 6: W = p->in[20]; off = WS_WT_C; K = 1024; N = 4096; kind = 2; break;
            default: W = p->in[22]; off = WS_WT_OC; K = 1024; N = 1024; kind = 0; break;
        }
        u16* WT = (u16*)(p->ws + off);
        const int ntn = N >> 8, ntiles = (K >> 6) * ntn;
        for (int tile = (int)gridDim.x - 1 - (int)blockIdx.x; tile < ntiles; tile += gridDim.x) {
            const int k0 = (tile / ntn) << 6, n0 = (tile % ntn) << 8;
            f32x4 v[8];
#pragma unroll
            for (int i = 0; i < 8; ++i) {
                const int row = (tid >> 4) + 32 * (i & 1), col4 = (i >> 1) * 64 + (tid & 15) * 4;
                v[i] = *(const f32x4*)(W + (size_t)(k0 + row) * N + n0 + col4);
            }
#pragma unroll
            for (int i = 0; i < 8; ++i) {
                const int row = (tid >> 4) + 32 * (i & 1), c4 = (tid & 15) * 4;
                LAS u16* t = sT + (i >> 1) * 4608;
                t[(c4 + 0) * 72 + row] = f2bf(v[i][0]); t[(c4 + 1) * 72 + row] = f2bf(v[i][1]);
                t[(c4 + 2) * 72 + row] = f2bf(v[i][2]); t[(c4 + 3) * 72 + row] = f2bf(v[i][3]);
            }
            __syncthreads();
            const int n = tid >> 3, ks = (tid & 7) * 8;
#pragma unroll
            for (int sub = 0; sub < 4; ++sub) {
                const bf16x8 o = *(const LAS bf16x8*)(sT + sub * 4608 + n * 72 + ks);
                *(bf16x8*)(WT + (size_t)perm_col(kind, n0 + sub * 64 + n) * K + k0 + ks) = o;
            }
            __syncthreads();
        }
    }
    for (int e = blockIdx.x * NTHREADS + tid; e < 32768; e += gridDim.x * NTHREADS) {
        const int t = e >> 5, dd = e & 31, f = dd & 15;
        const float inv = exp2f(-(float)f * (13.287712379549449f / 16.0f));
        const float pos = (dd < 16) ? (float)(t >> 6) : (float)(t & 63);
        const float ang = pos * inv;
        float* o = (float*)(p->ws + WS_ROPE) + (size_t)e * 2;
        o[0] = cosf(ang); o[1] = sinf(ang);
    }
}

__device__ __forceinline__ void cache_convert(KP p, int j) {
    const int gt = blockIdx.x * NTHREADS + tid_l(), gs = gridDim.x * NTHREADS;
    for (int idx = gt; idx < 4 * 256 * 8 * 16; idx += gs) {
        const int d8 = idx & 15, h = (idx >> 4) & 7, s = (idx >> 7) & 255, b = idx >> 15;
        const float* src = p->in[2] + ((size_t)((b * 2 + j) * 256 + s) * 8 + h) * 128 + d8 * 8;
        const f32x4 v0 = *(const f32x4*)src, v1 = *(const f32x4*)(src + 4);
        const int mm = d8 >> 3, d = (d8 & 7) * 8;
        u16* dst = (u16*)(p->ws + UA_KL) + ((size_t)((b * 8 + h) * 2 + mm) * 1280 + 1024 + s) * 64 + d;
        pg8::u32x4 o; o.x = pk2(v0[0], v0[1]); o.y = pk2(v0[2], v0[3]); o.z = pk2(v1[0], v1[1]); o.w = pk2(v1[2], v1[3]);
        *(pg8::u32x4*)dst = o;
    }
    for (int idx = gt; idx < 4 * 256 * 8 * 16; idx += gs) {
        const int s = idx & 255, d8 = (idx >> 8) & 15, h = (idx >> 12) & 7, b = idx >> 15;
        const float* src = p->in[3] + ((size_t)((b * 2 + j) * 256 + s) * 8 + h) * 128 + d8 * 8;
        const f32x4 v0 = *(const f32x4*)src, v1 = *(const f32x4*)(src + 4);
        u16* dst = (u16*)(p->ws + UA_VTL) + ((size_t)(b * 8 + h) * 128 + d8 * 8) * 1280 + 1024 + s;
        dst[0] = f2bf(v0[0]); dst[1280] = f2bf(v0[1]); dst[2560] = f2bf(v0[2]); dst[3840] = f2bf(v0[3]);
        dst[5120] = f2bf(v1[0]); dst[6400] = f2bf(v1[1]); dst[7680] = f2bf(v1[2]); dst[8960] = f2bf(v1[3]);
    }
}

__device__ __forceinline__ void phase_p0b(KP p) {
    const float* mod = (const float*)(p->ws + WS_MOD);
    u16* A = (u16*)(p->ws + WS_ABUF);
    for (int idx = blockIdx.x * NTHREADS + tid_l(); idx < 8192 * 128; idx += gridDim.x * NTHREADS) {
        const int r = idx >> 7, c = (idx & 127) * 8;
        const float* x = (r < 4096) ? p->in[0] + (size_t)r * 1024 + c : p->in[1] + (size_t)(r - 4096) * 1024 + c;
        const float* md = mod + (size_t)row_n5(r) * 3072;
        const f32x4 x0 = *(const f32x4*)x, x1 = *(const f32x4*)(x + 4);
        const f32x4 sh0 = *(const f32x4*)(md + c), sh1 = *(const f32x4*)(md + c + 4), sc0 = *(const f32x4*)(md + 1024 + c), sc1 = *(const f32x4*)(md + 1024 + c + 4);
        const f32x4 h0 = x0 * (sc0 + 1.0f) + sh0, h1 = x1 * (sc1 + 1.0f) + sh1;
        pg8::u32x4 o; o.x = pk2(h0[0], h0[1]); o.y = pk2(h0[2], h0[3]); o.z = pk2(h1[0], h1[1]); o.w = pk2(h1[2], h1[3]);
        *(pg8::u32x4*)(A + (size_t)r * 1024 + c) = o;
    }
}

__device__ __forceinline__ void phase_ln(KP p, int li, int nxt) {
    const int tid = tid_l(), w = tid >> 6, lane = tid & 63;
    const float* g = p->in[10] + li * 1024; const float* bb = p->in[11] + li * 1024;
    u16* A = (u16*)(p->ws + WS_ABUF);
    for (int r = blockIdx.x * 8 + w; r < 8192; r += gridDim.x * 8) {
        float* x = p->out + (size_t)r * 1024;
        f32x4 v[4];
        float s = 0.f;
#pragma unroll
        for (int q = 0; q < 4; ++q) { v[q] = *(const f32x4*)(x + q * 256 + lane * 4); s += v[q][0] + v[q][1] + v[q][2] + v[q][3]; }
#pragma unroll
        for (int o = 32; o; o >>= 1) s += __shfl_xor(s, o, 64);
        const float mu = s * (1.0f / 1024.0f);
        float ss = 0.f;
#pragma unroll
        for (int q = 0; q < 4; ++q) { v[q] = v[q] - mu; ss += v[q][0] * v[q][0] + v[q][1] * v[q][1] + v[q][2] * v[q][2] + v[q][3] * v[q][3]; }
#pragma unroll
        for (int o = 32; o; o >>= 1) ss += __shfl_xor(ss, o, 64);
        const float rstd = rsqrtf(ss * (1.0f / 1024.0f) + 1e-5f);
        const float* md = (const float*)(p->ws + WS_MOD) + ((size_t)(nxt < 4 ? nxt : 0) * 5 + row_n5(r)) * 3072;
#pragma unroll
        for (int q = 0; q < 4; ++q) {
            const int c = q * 256 + lane * 4;
            const f32x4 xn = v[q] * rstd * *(const f32x4*)(g + c) + *(const f32x4*)(bb + c);
            *(f32x4*)(x + c) = xn;
            if (nxt < 4) {
                const f32x4 h = xn * (*(const f32x4*)(md + 1024 + c) + 1.0f) + *(const f32x4*)(md + c);
                *(u32x2*)(A + (size_t)r * 1024 + c) = pk4(h);
            }
        }
    }
}

__device__ __forceinline__ void phase_attn(KP p, int j, LAS unsigned char* lds) {
    const int tid = tid_l(), w = tid >> 6, lane = tid & 63, lr = lane & 15, lq = lane >> 4;
    LAS u16* sm = (LAS u16*)lds;
    LAS u16* pb = sm + 36864 + w * 2304;
    float la = p->in[13][j * 256 + lane] * p->in[13][j * 256 + 64 + lane], lb = p->in[13][j * 256 + 128 + lane] * p->in[13][j * 256 + 192 + lane];
#pragma unroll
    for (int o = 32; o; o >>= 1) { la += __shfl_xor(la, o, 64); lb += __shfl_xor(lb, o, 64); }
    const float lam_init = p->lam_init[j];
    const float lamv = __expf(la) - __expf(lb) + lam_init;
    const float* subln = p->in[14] + j * 128;
    const u16* Q = (const u16*)(p->ws + UA_Q);
    const u16* Z = (const u16*)(p->ws + UA_Z);
    u16* A = (u16*)(p->ws + WS_ABUF);
    const float SC = 0.125f * LOG2E;
    for (int it = blockIdx.x; it < 512; it += gridDim.x) {
        int b, h, r0, nkeys; const u16* Kb; const u16* Vb;
        if (it < 256) { b = it >> 6; h = (it >> 3) & 7; r0 = 4096 + b * 1024 + (it & 7) * 128; nkeys = 1280;
            Kb = (const u16*)(p->ws + UA_KL) + (size_t)(b * 8 + h) * 2 * 1280 * 64; Vb = (const u16*)(p->ws + UA_VTL) + (size_t)(b * 8 + h) * 128 * 1280; }
        else { const int i2 = it - 256; b = i2 >> 4; h = (i2 >> 1) & 7; r0 = b * 256 + (i2 & 1) * 128; nkeys = 256;
            Kb = (const u16*)(p->ws + UA_KC) + (size_t)(b * 8 + h) * 2 * 256 * 64; Vb = (const u16*)(p->ws + UA_VTC) + (size_t)(b * 8 + h) * 128 * 256; }
        const int row_a = r0 + w * 16 + lr;
        bf16x8 qf[2][2];
#pragma unroll
        for (int m = 0; m < 2; ++m)
#pragma unroll
            for (int ks = 0; ks < 2; ++ks) qf[m][ks] = *(const bf16x8*)(Q + (size_t)row_a * 1024 + h * 128 + m * 64 + ks * 32 + lq * 8);
        f32x4 O[2][8];
        float mrow[2][4], lsum[2][4];
#pragma unroll
        for (int m = 0; m < 2; ++m) {
#pragma unroll
            for (int n = 0; n < 8; ++n) O[m][n] = (f32x4){0.f, 0.f, 0.f, 0.f};
#pragma unroll
            for (int i = 0; i < 4; ++i) { mrow[m][i] = -1e30f; lsum[m][i] = 0.f; }
        }
        const int ntiles = nkeys >> 6;
        const int krow = tid >> 3, kseg = (tid & 7) * 8, vrow = tid >> 2, vseg = (tid & 3) * 16;
        bf16x8 g0, g1, g2, g3;
        g0 = *(const bf16x8*)(Kb + (size_t)krow * 64 + kseg);
        g1 = *(const bf16x8*)(Kb + (size_t)(nkeys + krow) * 64 + kseg);
        g2 = *(const bf16x8*)(Vb + (size_t)vrow * nkeys + vseg);
        g3 = *(const bf16x8*)(Vb + (size_t)vrow * nkeys + vseg + 8);
        *(LAS bf16x8*)(sm + krow * 72 + kseg) = g0; *(LAS bf16x8*)(sm + 4608 + krow * 72 + kseg) = g1;
        *(LAS bf16x8*)(sm + 9216 + vrow * 72 + vseg) = g2; *(LAS bf16x8*)(sm + 9216 + vrow * 72 + vseg + 8) = g3;
        __syncthreads();
        for (int kt = 0; kt < ntiles; ++kt) {
            const int cur = kt & 1;
            const bool more = kt + 1 < ntiles;
            if (more) {
                const int k0 = (kt + 1) * 64;
                g0 = *(const bf16x8*)(Kb + (size_t)(k0 + krow) * 64 + kseg);
                g1 = *(const bf16x8*)(Kb + (size_t)(nkeys + k0 + krow) * 64 + kseg);
                g2 = *(const bf16x8*)(Vb + (size_t)vrow * nkeys + k0 + vseg);
                g3 = *(const bf16x8*)(Vb + (size_t)vrow * nkeys + k0 + vseg + 8);
            }
            const LAS u16* bK = sm + cur * 18432; const LAS u16* bV = bK + 9216;
            f32x4 s[2][4];
#pragma unroll
            for (int m = 0; m < 2; ++m)
#pragma unroll
                for (int n = 0; n < 4; ++n) s[m][n] = (f32x4){0.f, 0.f, 0.f, 0.f};
#pragma unroll
            for (int m = 0; m < 2; ++m)
#pragma unroll
                for (int ks = 0; ks < 2; ++ks)
#pragma unroll
                    for (int n = 0; n < 4; ++n) {
                        const bf16x8 kf = *(const LAS bf16x8*)(bK + m * 4608 + (n * 16 + lr) * 72 + ks * 32 + lq * 8);
                        s[m][n] = MFMA16(qf[m][ks], kf, s[m][n]);
                    }
#pragma unroll
            for (int m = 0; m < 2; ++m) {
#pragma unroll
                for (int i = 0; i < 4; ++i) {
                    float mx = -1e30f;
#pragma unroll
                    for (int n = 0; n < 4; ++n) { s[m][n][i] *= SC; mx = fmaxf(mx, s[m][n][i]); }
                    mx = fmaxf(mx, __shfl_xor(mx, 1, 64)); mx = fmaxf(mx, __shfl_xor(mx, 2, 64));
                    mx = fmaxf(mx, __shfl_xor(mx, 4, 64)); mx = fmaxf(mx, __shfl_xor(mx, 8, 64));
                    const float mn = fmaxf(mrow[m][i], mx);
                    const float al = ex2(mrow[m][i] - mn);
                    mrow[m][i] = mn;
                    float ls = lsum[m][i] * al;
#pragma unroll
                    for (int n = 0; n < 8; ++n) O[m][n][i] *= al;
#pragma unroll
                    for (int n = 0; n < 4; ++n) {
                        const float pv = ex2(s[m][n][i] - mn);
                        ls += pv;
                        pb[m * 1152 + (lq * 4 + i) * 72 + n * 16 + lr] = f2bf(pv);
                    }
                    lsum[m][i] = ls;
                }
            }
            asm volatile("s_waitcnt lgkmcnt(0)" ::: "memory");
#pragma unroll
            for (int ks = 0; ks < 2; ++ks) {
                const bf16x8 p0 = *(const LAS bf16x8*)(pb + lr * 72 + ks * 32 + lq * 8);
                const bf16x8 p1 = *(const LAS bf16x8*)(pb + 1152 + lr * 72 + ks * 32 + lq * 8);
#pragma unroll
                for (int n = 0; n < 8; ++n) {
                    const bf16x8 vf = *(const LAS bf16x8*)(bV + (n * 16 + lr) * 72 + ks * 32 + lq * 8);
                    O[0][n] = MFMA16(p0, vf, O[0][n]);
                    O[1][n] = MFMA16(p1, vf, O[1][n]);
                }
            }
            if (more) {
                LAS u16* nb = sm + (cur ^ 1) * 18432;
                *(LAS bf16x8*)(nb + krow * 72 + kseg) = g0; *(LAS bf16x8*)(nb + 4608 + krow * 72 + kseg) = g1;
                *(LAS bf16x8*)(nb + 9216 + vrow * 72 + vseg) = g2; *(LAS bf16x8*)(nb + 9216 + vrow * 72 + vseg + 8) = g3;
            }
            __syncthreads();
        }
#pragma unroll
        for (int i = 0; i < 4; ++i) {
            float l0 = lsum[0][i], l1 = lsum[1][i];
#pragma unroll
            for (int o = 1; o < 16; o <<= 1) { l0 += __shfl_xor(l0, o, 64); l1 += __shfl_xor(l1, o, 64); }
            const float i0 = 1.0f / l0, i1 = lamv / l1;
            float ov[8]; float ss = 0.f;
#pragma unroll
            for (int n = 0; n < 8; ++n) { ov[n] = O[0][n][i] * i0 - O[1][n][i] * i1; ss += ov[n] * ov[n]; }
#pragma unroll
            for (int o = 1; o < 16; o <<= 1) ss += __shfl_xor(ss, o, 64);
            const float rstd = rsqrtf(ss * (1.0f / 128.0f) + 1e-6f) * (1.0f - lam_init);
            const int r = r0 + w * 16 + lq * 4 + i;
#pragma unroll
            for (int n = 0; n < 8; ++n) {
                const int dv = n * 16 + lr;
                const float zz = bf2f(Z[(size_t)r * 1024 + h * 128 + dv]);
                A[(size_t)r * 1024 + h * 128 + dv] = f2bf(ov[n] * rstd * subln[dv] * zz);
            }
        }
    }
}

__device__ __forceinline__ void phase_ret(KP p, LAS unsigned char* lds) {
    const int tid = tid_l(), w = tid >> 6, lane = tid & 63, lr = lane & 15, lq = lane >> 4;
    LAS u16* RK = (LAS u16*)lds;
    LAS u16* RP = (LAS u16*)lds + w * 2176;
    LAS u16* RV0 = (LAS u16*)lds + 33792;
    LAS u16* RV1 = (LAS u16*)lds + 42496;
    LAS u16* RS = (LAS u16*)lds + 51200;
    const u16* QR = (const u16*)(p->ws + UR_QR); const u16* KR = (const u16*)(p->ws + UR_KR);
    const u16* KTR = (const u16*)(p->ws + UR_KTR); const u16* VTR = (const u16*)(p->ws + UR_VTR);
    u16* OB = (u16*)(p->ws + UR_O); u16* SB = (u16*)(p->ws + UR_SB);
    const int G = gridDim.x;
    const int nlb = (G / 2 < 128) ? G / 2 : 128;
    int first, stride, limit;
    if ((int)blockIdx.x < nlb) { first = blockIdx.x; stride = nlb; limit = 128; }
    else { first = 128 + blockIdx.x - nlb; stride = G - nlb; limit = 640; }
    for (int it = first; it < limit; it += stride) {
        const bool lat = it < 128;
        int b, h, ds, r0, nc;
        if (lat) { b = it >> 5; h = (it >> 3) & 3; ds = it & 7; r0 = 4096 + b * 1024; nc = 8; }
        else { const int i2 = it - 128; b = i2 >> 5; h = (i2 >> 3) & 3; ds = i2 & 7; r0 = b * 256; nc = 2; }
        const float lgf2 = log1pf(-expf(p->in[17][h])) * LOG2E, lgb2 = log1pf(-expf(p->in[18][h])) * LOG2E;
        const float cdf = ex2(128.0f * lgf2), cdb = ex2(128.0f * lgb2);
        u16* slots = lat ? SB + (size_t)it * 8 * 16384 : SB + (size_t)(1024 + it - 128) * 16384;
        const size_t st_off = (size_t)(b * 4 + h) * 131072 + ds * 64;
        const u16* ktw = KTR + (size_t)(h * 256 + w * 32 + lr) * 8192 + r0 + lq * 8;
        f32x4 S[2][4];
#pragma unroll
        for (int mt = 0; mt < 2; ++mt)
#pragma unroll
            for (int nt = 0; nt < 4; ++nt)
#pragma unroll
                for (int i = 0; i < 4; ++i)
                    S[mt][nt][i] = lat ? p->in[5][st_off + (size_t)(w * 32 + mt * 16 + lq * 4 + i) * 512 + nt * 16 + lr] : 0.f;
        if (lat) {
#pragma unroll
            for (int mt = 0; mt < 2; ++mt)
#pragma unroll
                for (int nt = 0; nt < 4; ++nt)
                    *(u32x2*)(slots + (size_t)(nc - 1) * 16384 + (nt * 16 + lr) * 256 + w * 32 + mt * 16 + lq * 4) = pk4(S[mt][nt]);
        }
        for (int c = nc - 1; c >= (lat ? 1 : 0); --c) {
            float lb = lgb2; int tv = tid; asm volatile("" : "+v"(lb), "+v"(tv));
            __syncthreads();
#pragma unroll
            for (int k = 0; k < 2; ++k) {
                const int idx = tv + k * 512, row = idx >> 4, seg = idx & 15;
                const bf16x8 v = *(const bf16x8*)(VTR + (size_t)(h * 512 + ds * 64 + row) * 8192 + r0 + c * 128 + seg * 8);
                bf16x8 o;
#pragma unroll
                for (int q = 0; q < 8; ++q) o[q] = (short)f2bf(bf2f((u16)v[q]) * ex2(lb * (float)(seg * 8 + q)));
                *(LAS bf16x8*)(RV1 + row * 136 + seg * 8) = o;
            }
            __syncthreads();
#pragma unroll
            for (int mt = 0; mt < 2; ++mt)
#pragma unroll
                for (int nt = 0; nt < 4; ++nt) S[mt][nt] = S[mt][nt] * cdb;
#pragma unroll
            for (int ks = 0; ks < 4; ++ks) {
                bf16x8 kf[2];
#pragma unroll
                for (int mt = 0; mt < 2; ++mt) kf[mt] = *(const bf16x8*)(ktw + (size_t)mt * 16 * 8192 + c * 128 + ks * 32);
#pragma unroll
                for (int nt = 0; nt < 4; ++nt) {
                    const bf16x8 vf = *(const LAS bf16x8*)(RV1 + (nt * 16 + lr) * 136 + ks * 32 + lq * 8);
#pragma unroll
                    for (int mt = 0; mt < 2; ++mt) S[mt][nt] = MFMA16(kf[mt], vf, S[mt][nt]);
                }
            }
            if (c >= 1) {
#pragma unroll
                for (int mt = 0; mt < 2; ++mt)
#pragma unroll
                    for (int nt = 0; nt < 4; ++nt)
                        *(u32x2*)(slots + (size_t)(c - 1) * 16384 + (nt * 16 + lr) * 256 + w * 32 + mt * 16 + lq * 4) = pk4(S[mt][nt]);
            }
        }
        if (!lat) {
#pragma unroll
            for (int mt = 0; mt < 2; ++mt)
#pragma unroll
                for (int nt = 0; nt < 4; ++nt)
#pragma unroll
                    for (int i = 0; i < 4; ++i)
                        p->out[OUT_NSB + st_off + (size_t)(w * 32 + mt * 16 + lq * 4 + i) * 512 + nt * 16 + lr] = S[mt][nt][i];
        }
        __threadfence();
#pragma unroll
        for (int mt = 0; mt < 2; ++mt)
#pragma unroll
            for (int nt = 0; nt < 4; ++nt)
#pragma unroll
                for (int i = 0; i < 4; ++i)
                    S[mt][nt][i] = lat ? p->in[4][st_off + (size_t)(w * 32 + mt * 16 + lq * 4 + i) * 512 + nt * 16 + lr] : 0.f;
        for (int c = 0; c < nc; ++c) {
            const bool has_f = lat || c > 0, has_b = lat || c < nc - 1;
            const int rc = r0 + c * 128;
            float lf = lgf2, lb = lgb2; int tv = tid, lqv = lq, lrv = lr; asm volatile("" : "+v"(lf), "+v"(lb), "+v"(tv), "+v"(lqv), "+v"(lrv));
            __syncthreads();
#pragma unroll
            for (int k = 0; k < 8; ++k) {
                const int idx = tid + k * 512, row = idx >> 5, seg = idx & 31;
                *(LAS bf16x8*)(RK + row * 264 + seg * 8) = *(const bf16x8*)(KR + (size_t)(rc + row) * 1024 + h * 256 + seg * 8);
            }
#pragma unroll
            for (int k = 0; k < 2; ++k) {
                const int idx = tv + k * 512, row = idx >> 4, seg = idx & 15;
                const bf16x8 v = *(const bf16x8*)(VTR + (size_t)(h * 512 + ds * 64 + row) * 8192 + rc + seg * 8);
                bf16x8 o;
#pragma unroll
                for (int q = 0; q < 8; ++q) o[q] = (short)f2bf(bf2f((u16)v[q]) * ex2(lf * (float)(127 - seg * 8 - q)));
                *(LAS bf16x8*)(RV0 + row * 136 + seg * 8) = v;
                *(LAS bf16x8*)(RV1 + row * 136 + seg * 8) = o;
            }
            if (has_f) {
#pragma unroll
                for (int mt = 0; mt < 2; ++mt)
#pragma unroll
                    for (int nt = 0; nt < 4; ++nt)
                        *(LAS u32x2*)(RS + (nt * 16 + lr) * 264 + w * 32 + mt * 16 + lq * 4) = pk4(S[mt][nt]);
            }
            bf16x8 qf[8];
#pragma unroll
            for (int ks = 0; ks < 8; ++ks) qf[ks] = *(const bf16x8*)(QR + (size_t)(rc + w * 16 + lr) * 1024 + h * 256 + ks * 32 + lq * 8);
            __syncthreads();
            __builtin_amdgcn_sched_barrier(0);
            f32x4 P[8], O[4];
#pragma unroll
            for (int nt = 0; nt < 8; ++nt) P[nt] = (f32x4){0.f, 0.f, 0.f, 0.f};
#pragma unroll
            for (int nt = 0; nt < 4; ++nt) O[nt] = (f32x4){0.f, 0.f, 0.f, 0.f};
#pragma unroll
            for (int ks = 0; ks < 8; ++ks)
#pragma unroll
                for (int nt = 0; nt < 8; ++nt) {
                    const bf16x8 kf = *(const LAS bf16x8*)(RK + (nt * 16 + lr) * 264 + ks * 32 + lq * 8);
                    P[nt] = MFMA16(qf[ks], kf, P[nt]);
                }
            if (has_f) {
#pragma unroll
                for (int ks = 0; ks < 8; ++ks)
#pragma unroll
                    for (int nt = 0; nt < 4; ++nt) {
                        const bf16x8 sf = *(const LAS bf16x8*)(RS + (nt * 16 + lr) * 264 + ks * 32 + lq * 8);
                        O[nt] = MFMA16(qf[ks], sf, O[nt]);
                    }
#pragma unroll
                for (int i = 0; i < 4; ++i) {
                    const float qd = ex2(lf * (float)(w * 16 + lqv * 4 + i + 1));
#pragma unroll
                    for (int nt = 0; nt < 4; ++nt) O[nt][i] *= qd;
                }
            }
            __syncthreads();
            __builtin_amdgcn_sched_barrier(0);
#pragma unroll
            for (int nt = 0; nt < 8; ++nt)
#pragma unroll
                for (int i = 0; i < 4; ++i) {
                    const int n = w * 16 + lqv * 4 + i, m = nt * 16 + lrv, df = n - m;
                    const float dm = df > 0 ? ex2(lf * (float)df) : (df < 0 ? ex2(lb * (float)(-df)) : 2.0f);
                    RP[(lq * 4 + i) * 136 + nt * 16 + lr] = f2bf(P[nt][i] * dm);
                }
            if (has_b) {
#pragma unroll
                for (int k = 0; k < 4; ++k) {
                    const int idx = tid + k * 512, row = idx >> 5, seg = idx & 31;
                    *(LAS bf16x8*)(RS + row * 264 + seg * 8) = *(const bf16x8*)(slots + (size_t)c * 16384 + row * 256 + seg * 8);
                }
            }
            __syncthreads();
            __builtin_amdgcn_sched_barrier(0);
            if (has_b) {
#pragma unroll
                for (int ks = 0; ks < 8; ++ks) qf[ks] = *(const bf16x8*)(QR + (size_t)(rc + w * 16 + lr) * 1024 + h * 256 + ks * 32 + lq * 8);
                f32x4 Ob[4];
#pragma unroll
                for (int nt = 0; nt < 4; ++nt) Ob[nt] = (f32x4){0.f, 0.f, 0.f, 0.f};
#pragma unroll
                for (int ks = 0; ks < 8; ++ks)
#pragma unroll
                    for (int nt = 0; nt < 4; ++nt) {
                        const bf16x8 sf = *(const LAS bf16x8*)(RS + (nt * 16 + lr) * 264 + ks * 32 + lq * 8);
                        Ob[nt] = MFMA16(qf[ks], sf, Ob[nt]);
                    }
#pragma unroll
                for (int i = 0; i < 4; ++i) {
                    const float qd = ex2(lb * (float)(128 - (w * 16 + lqv * 4 + i)));
#pragma unroll
                    for (int nt = 0; nt < 4; ++nt) O[nt][i] += Ob[nt][i] * qd;
                }
            }
            __builtin_amdgcn_sched_barrier(0);
#pragma unroll
            for (int ks = 0; ks < 4; ++ks) {
                const bf16x8 pf = *(const LAS bf16x8*)(RP + lr * 136 + ks * 32 + lq * 8);
#pragma unroll
                for (int nt = 0; nt < 4; ++nt) {
                    const bf16x8 vf = *(const LAS bf16x8*)(RV0 + (nt * 16 + lr) * 136 + ks * 32 + lq * 8);
                    O[nt] = MFMA16(pf, vf, O[nt]);
                }
            }
            __builtin_amdgcn_sched_barrier(0);
#pragma unroll
            for (int mt = 0; mt < 2; ++mt)
#pragma unroll
                for (int nt = 0; nt < 4; ++nt) S[mt][nt] = S[mt][nt] * cdf;
#pragma unroll
            for (int ks = 0; ks < 4; ++ks) {
                bf16x8 kf[2];
#pragma unroll
                for (int mt = 0; mt < 2; ++mt) kf[mt] = *(const bf16x8*)(ktw + (size_t)mt * 16 * 8192 + c * 128 + ks * 32);
#pragma unroll
                for (int nt = 0; nt < 4; ++nt) {
                    const bf16x8 vf = *(const LAS bf16x8*)(RV1 + (nt * 16 + lr) * 136 + ks * 32 + lq * 8);
#pragma unroll
                    for (int mt = 0; mt < 2; ++mt) S[mt][nt] = MFMA16(kf[mt], vf, S[mt][nt]);
                }
            }
            __builtin_amdgcn_sched_barrier(0);
#pragma unroll
            for (int nt = 0; nt < 4; ++nt)
#pragma unroll
                for (int i = 0; i < 4; ++i)
                    OB[(size_t)(rc + w * 16 + lq * 4 + i) * 2048 + h * 512 + ds * 64 + nt * 16 + lr] = f2bf(O[nt][i]);
        }
        if (!lat) {
#pragma unroll
            for (int mt = 0; mt < 2; ++mt)
#pragma unroll
                for (int nt = 0; nt < 4; ++nt)
#pragma unroll
                    for (int i = 0; i < 4; ++i)
                        p->out[OUT_NSF + st_off + (size_t)(w * 32 + mt * 16 + lq * 4 + i) * 512 + nt * 16 + lr] = S[mt][nt][i];
        }
    }
}

__device__ __forceinline__ void phase_retfin(KP p) {
    const int tid = tid_l(), w = tid >> 6, lane = tid & 63;
    const u16* OB = (const u16*)(p->ws + UR_O); const u16* Gb = (const u16*)(p->ws + UR_G);
    u16* A2 = (u16*)(p->ws + UR_QR);
    for (int rh = blockIdx.x * 8 + w; rh < 8192 * 4; rh += gridDim.x * 8) {
        const size_t off = (size_t)(rh >> 2) * 2048 + (rh & 3) * 512 + lane * 8;
        const bf16x8 o = *(const bf16x8*)(OB + off), g = *(const bf16x8*)(Gb + off);
        float of[8]; float ss = 0.f;
#pragma unroll
        for (int q = 0; q < 8; ++q) { of[q] = bf2f((u16)o[q]); ss += of[q] * of[q]; }
#pragma unroll
        for (int s = 32; s; s >>= 1) ss += __shfl_xor(ss, s, 64);
        const float rstd = rsqrtf(ss * (1.0f / 512.0f) + 1e-6f);
        bf16x8 a;
#pragma unroll
        for (int q = 0; q < 8; ++q) a[q] = (short)f2bf(of[q] * rstd * bf2f((u16)g[q]));
        *(bf16x8*)(A2 + off) = a;
    }
}

__device__ __forceinline__ void phase_convfin(KP p) {
    const u16* T1 = (const u16*)(p->ws + UC_T1); const u16* PC = (const u16*)(p->ws + UC_PC);
    u16* A = (u16*)(p->ws + WS_ABUF);
    const float* cw = p->in[21];
    for (int idx = blockIdx.x * NTHREADS + tid_l(); idx < 8192 * 128; idx += gridDim.x * NTHREADS) {
        const int r = idx >> 7, e = (idx & 127) * 8;
        const int t = r < 4096 ? (r & 255) : (r & 1023), T = r < 4096 ? 256 : 1024;
        const size_t off = (size_t)r * 1024 + e;
        const bf16x8 t1 = *(const bf16x8*)(T1 + off), pc = *(const bf16x8*)(PC + off);
        bf16x8 pp, pn;
#pragma unroll
        for (int q = 0; q < 8; ++q) { pp[q] = 0; pn[q] = 0; }
        if (t > 0) pp = *(const bf16x8*)(PC + off - 1024);
        if (t < T - 1) pn = *(const bf16x8*)(PC + off + 1024);
        bf16x8 a;
#pragma unroll
        for (int q = 0; q < 8; ++q) {
            const float cv = cw[e + q] * bf2f((u16)pp[q]) + cw[1024 + e + q] * bf2f((u16)pc[q]) + cw[2048 + e + q] * bf2f((u16)pn[q]);
            a[q] = (short)f2bf(bf2f((u16)t1[q]) * cv);
        }
        *(bf16x8*)(A + off) = a;
    }
}

__global__ void __launch_bounds__(512) mega(Prm p_unused) {
    const KP kp = (KP)__builtin_amdgcn_kernarg_segment_ptr();
    extern __shared__ __attribute__((aligned(16))) unsigned char shm[];
    LAS unsigned char* lds = (LAS unsigned char*)shm;
    cg::grid_group grid = cg::this_grid();
    pg8::StaticOrder S;
    volatile LAS unsigned* xst = (volatile LAS unsigned*)(lds + LDS_MAIN);
    if (threadIdx.x == 0) { xst[0] = 0u; xst[1] = 0u; xst[2] = 0u; xst[3] = 0u; }
    __syncthreads();
    XcdBarrier xb = xcd_barrier_post((unsigned*)(kp->ws + WS_BAR), xst);
    phase_p0a(lp(kp), lds);
    grid.sync();
    phase_p0b(lp(kp));
    cache_convert(lp(kp), 0);
    xcd_barrier(xb);
    for (int li = 0; li < 4; ++li) {
        const int kind = li % 3, j = li / 3;
        const KP p = lp(kp);
        {
            pg8::Gemm g; g.A = (const u16*)(p->ws + WS_ABUF); g.M = 8192; g.K = 1024;
            if (kind == 0) { g.Bt = (const u16*)(p->ws + (j == 0 ? WS_WT_A0 : WS_WT_A1)); g.N = 4096; }
            else if (kind == 1) { g.Bt = (const u16*)(p->ws + WS_WT_B); g.N = 6144; }
            else { g.Bt = (const u16*)(p->ws + WS_WT_C); g.N = 4096; }
            Epi E; E.kind = kind; E.layer = li; E.j = j; E.p = lp(kp);
            S.init(g.M, g.N, (int)gridDim.x, (int)blockIdx.x);
            pg8::gemm_phase<Epi, pg8::StaticOrder, false>(lds, g, S, E, nullptr);
        }
        xcd_barrier(xb);
        if (kind == 0) { phase_attn(lp(kp), j, lds); }
        else if (kind == 1) { phase_ret(lp(kp), lds); xcd_barrier(xb); phase_retfin(lp(kp)); }
        else { phase_convfin(lp(kp)); }
        xcd_barrier(xb);
        {
            pg8::Gemm g; g.M = 8192; g.N = 1024;
            if (kind == 0) { g.A = (const u16*)(p->ws + WS_ABUF); g.Bt = (const u16*)(p->ws + (j == 0 ? WS_WT_OA0 : WS_WT_OA1)); g.K = 1024; }
            else if (kind == 1) { g.A = (const u16*)(p->ws + UR_QR); g.Bt = (const u16*)(p->ws + WS_WT_OB); g.K = 2048; }
            else { g.A = (const u16*)(p->ws + WS_ABUF); g.Bt = (const u16*)(p->ws + WS_WT_OC); g.K = 1024; }
            Epi E; E.kind = 3; E.layer = li; E.j = j; E.p = lp(kp);
            S.init(g.M, g.N, (int)gridDim.x, (int)blockIdx.x);
            pg8::gemm_phase<Epi, pg8::StaticOrder, false>(lds, g, S, E, nullptr);
        }
        xcd_barrier(xb);
        phase_ln(lp(kp), li, li + 1);
        if (li == 2) cache_convert(lp(kp), 1);
        xcd_barrier(xb);
    }
}

extern "C" void kernel_launch(void* const* d_in, const int* in_sizes, int n_in, void* d_out, int out_size, void* d_ws, size_t ws_size, hipStream_t stream) {
    static int grid_blocks = 0;
    if (!grid_blocks) {
        int dev = 0, cus = 0, per_cu = 0;
        hipGetDevice(&dev);
        hipDeviceGetAttribute(&cus, hipDeviceAttributeMultiprocessorCount, dev);
        hipFuncSetAttribute((const void*)mega, hipFuncAttributeMaxDynamicSharedMemorySize, LDS_BYTES);
        hipOccupancyMaxActiveBlocksPerMultiprocessor(&per_cu, mega, NTHREADS, LDS_BYTES);
        if (per_cu < 1) per_cu = 1;
        if (per_cu > 1) per_cu = 1;
        grid_blocks = cus * per_cu;
        if (ws_size < WS_NEEDED) fprintf(stderr, "workspace too small: %zu < %zu\n", ws_size, (size_t)WS_NEEDED);
    }
    Prm p{};
    for (int i = 0; i < 23; ++i) p.in[i] = (const float*)d_in[i];
    p.out = (float*)d_out;
    p.ws = (char*)d_ws;
    p.lam_init[0] = (float)(0.8 - 0.6 * exp(-0.3 * 0.0));
    p.lam_init[1] = (float)(0.8 - 0.6 * exp(-0.3 * 3.0));
    hipMemsetAsync((char*)d_ws + WS_BAR, 0, 16384, stream);
    void* args[] = {&p};
    hipError_t e = hipLaunchCooperativeKernel((void*)mega, dim3(grid_blocks), dim3(NTHREADS), args, LDS_BYTES, stream);
    if (e != hipSuccess) fprintf(stderr, "cooperative launch failed: %s (grid %d)\n", hipGetErrorString(e), grid_blocks);
}
```

```cpp
#include <hip/hip_runtime.h>
#include <hip/hip_cooperative_groups.h>
#include <cstdio>
#include <cmath>
namespace cg = cooperative_groups;

namespace pg8 {
#define PG8_LAS __attribute__((address_space(3)))
typedef unsigned short bf16_t;
typedef short bf16x8 __attribute__((ext_vector_type(8)));
typedef float f32x4 __attribute__((ext_vector_type(4)));
typedef unsigned u32x4 __attribute__((ext_vector_type(4)));
constexpr int BM = 256, BK = 64, HALF = 128, HTB = HALF * BK * 2  , STAGE_BYTES = 8 * HTB, NXCD = 8, WGM = 8;
__host__ __device__ __forceinline__ int lds_byte(int r, int c) { const int st = (r >> 4) * 2 + (c >> 5), rr = r & 15, cc = c & 31, ob = rr * 64 + cc * 2; return st * 1024 + (ob ^ (((ob >> 9) & 1) << 5)); }
__host__ __device__ __forceinline__ void stage_rc(int b, int& R, int& C) { const int st = b / 1024, sb = b % 1024, swz = sb ^ (((sb >> 9) & 1) << 5); R = (st >> 1) * 16 + swz / 64; C = (st & 1) * 32 + (swz % 64) / 2; }
__host__ __device__ __forceinline__ int perm32(int rho) { const int n = rho >> 4, i = rho & 15; return 8 * (i >> 2) + 4 * n + (i & 3); }

struct Unit { int pm, pn; };
struct Gemm { const bf16_t* A; const bf16_t* Bt; int M, N, K; };

struct StaticOrder {
    int nM, nN, nwg, G, c;
    __host__ __device__ void init(int M, int N, int G_, int c_) { nM = M / BM; nN = N / BM; nwg = nM * nN; G = G_; c = c_; }
    __host__ __device__ bool next(int i, Unit& u) const {
        const long L = (long)i * G + c; if (L >= nwg) return false;
        int wgid = (int)L; { const int q = nwg / NXCD, r = nwg % NXCD, xcd = wgid % NXCD, off = wgid / NXCD; wgid = (xcd < r ? xcd * (q + 1) : r * (q + 1) + (xcd - r) * q) + off; }
        const int nig = WGM * nN, gid = wgid / nig, fm = gid * WGM, gsz = (nM - fm) < WGM ? (nM - fm) : WGM;
        u.pm = fm + ((wgid % nig) % gsz); u.pn = (wgid % nig) / gsz; return true;
    }
    __device__ __forceinline__ void a_ready(const Unit&) const {}
    __device__ __forceinline__ void done(const Unit&) const {}
};
template <class Epi, class Sched, bool STAMP = false>
__device__ __forceinline__ void gemm_phase(PG8_LAS unsigned char* lds, const Gemm g, const Sched& S, const Epi& E, unsigned long long* stamps) {
    int tid_ = threadIdx.x; asm volatile("" : "+v"(tid_)); const int tid = tid_, wid = __builtin_amdgcn_readfirstlane(tid >> 6), lane = tid & 63, wr = wid >> 2, wc = wid & 3, fr = lane & 15, fq = lane >> 4;
    const int K = g.K, nt = K / BK;
    int ts_lo = 0, ts_hi = 0, nts = 0; const unsigned long long rt_entry = STAMP ? (unsigned long long)wall_clock64() : 0ull;
#define PG8_STAMP() do { if (STAMP && wid == 0 && nts < 64) { const unsigned long long _c = (unsigned long long)clock64(); \
        ts_lo = (lane == nts) ? (int)(unsigned)_c : ts_lo; ts_hi = (lane == nts) ? (int)(unsigned)(_c >> 32) : ts_hi; ++nts; } } while (0)
    PG8_STAMP();
    unsigned voffA[2], voffB[2];
#pragma unroll
    for (int i = 0; i < 2; ++i) { int R, C; stage_rc(tid * 16 + i * 8192, R, C); const int Rb = Epi::PERM ? ((R & ~31) + perm32(R & 31)) : R;
        voffA[i] = (unsigned)(R * K + C) * 2u; voffB[i] = (unsigned)(Rb * K + C) * 2u; }
    const size_t kstep = (size_t)(BK * 2);
    const size_t hstep = (size_t)HALF * K * 2;
    const size_t tstep = 2 * hstep;
    const unsigned ldsw = (unsigned)wid * 1024u;
    const int aoff = lds_byte(wr * 64 + fr, fq * 8), boff = lds_byte(wc * 32 + fr, fq * 8);
#define PG8_SA(b, h) (((b) * 2 + (h)) * HTB)
#define PG8_SB(b, h) ((4 + (b) * 2 + (h)) * HTB)
#define PG8_STAGE(bufoff, gbase, voff) do { _Pragma("unroll") for (int _i = 0; _i < 2; ++_i) \
        __builtin_amdgcn_global_load_lds((const unsigned*)((const char*)(gbase) + (voff)[_i]), (PG8_LAS unsigned*)(lds + (bufoff) + ldsw + _i * 8192), 16, 0, 0); } while (0)
#define PG8_LDA(dst, b, h) do { _Pragma("unroll") for (int m = 0; m < 4; ++m) _Pragma("unroll") for (int k = 0; k < 2; ++k) dst[m][k] = *(const PG8_LAS bf16x8*)(lds + PG8_SA(b, h) + aoff + m * 2048 + k * 1024); } while (0)
#define PG8_LDB(dst, b, h) do { _Pragma("unroll") for (int n = 0; n < 2; ++n) _Pragma("unroll") for (int k = 0; k < 2; ++k) dst[n][k] = *(const PG8_LAS bf16x8*)(lds + PG8_SB(b, h) + boff + n * 2048 + k * 1024); } while (0)
#define PG8_MMA(ai, bj, At, Bt) do { __builtin_amdgcn_s_setprio(1); _Pragma("unroll") for (int m = 0; m < 4; ++m) _Pragma("unroll") for (int n = 0; n < 2; ++n) _Pragma("unroll") for (int k = 0; k < 2; ++k) \
        acc[ai][bj][m][n] = __builtin_amdgcn_mfma_f32_16x16x32_bf16(Bt[n][k], At[m][k], acc[ai][bj][m][n], 0, 0, 0); __builtin_amdgcn_s_setprio(0); } while (0)
#define PG8_WAIT_V(n) asm volatile("s_waitcnt vmcnt(" #n ")" ::: "memory")
#define PG8_WAIT_L(n) asm volatile("s_waitcnt lgkmcnt(" #n ")" ::: "memory")
#define PG8_BAR __builtin_amdgcn_s_barrier()
#define PG8_SCHED __builtin_amdgcn_sched_barrier(0)
    Unit cur, nxt; int ui = 0;
    if (!S.next(0, cur)) return;
    f32x4 acc[2][2][4][2];
#pragma unroll
    for (int a = 0; a < 2; ++a)
#pragma unroll
        for (int b = 0; b < 2; ++b)
#pragma unroll
            for (int m = 0; m < 4; ++m)
#pragma unroll
                for (int n = 0; n < 2; ++n) acc[a][b][m][n] = (f32x4){0.f, 0.f, 0.f, 0.f};
    bf16x8 At[4][2], B0[2][2], B1[2][2];
    const char* cA = (const char*)g.A + (size_t)cur.pm * tstep; const char* cB = (const char*)g.Bt + (size_t)cur.pn * tstep;
    S.a_ready(cur);
    PG8_STAGE(PG8_SB(0, 0), cB, voffB); PG8_STAGE(PG8_SA(0, 0), cA, voffA); PG8_STAGE(PG8_SB(0, 1), cB + hstep, voffB); PG8_STAGE(PG8_SA(0, 1), cA + hstep, voffA);
    if (wr == 1) PG8_BAR;
    PG8_WAIT_V(4); PG8_BAR;
    PG8_STAGE(PG8_SB(1, 0), cB + kstep, voffB); PG8_STAGE(PG8_SA(1, 0), cA + kstep, voffA); PG8_STAGE(PG8_SB(1, 1), cB + hstep + kstep, voffB);
    PG8_WAIT_V(6); PG8_BAR;
    PG8_STAMP();
    for (;;) {
        const bool has_next = S.next(ui + 1, nxt);
        const char* nA = has_next ? (const char*)g.A + (size_t)nxt.pm * tstep : cA; const char* nB = has_next ? (const char*)g.Bt + (size_t)nxt.pn * tstep : cB;
        for (int t = 0; t < nt; t += 2) {
            const bool last = (t == nt - 2);
            const char* a1 = cA + (size_t)(t + 1) * kstep;
            const char* a2 = last ? nA : cA + (size_t)(t + 2) * kstep; const char* b2 = last ? nB : cB + (size_t)(t + 2) * kstep;
            const char* a3 = a2 + kstep; const char* b3 = b2 + kstep;
            if (last && has_next) S.a_ready(nxt);
            PG8_LDB(B0, 0, 0); PG8_SCHED; PG8_LDA(At, 0, 0); PG8_STAGE(PG8_SA(1, 1), a1 + hstep, voffA);
            PG8_WAIT_L(8); PG8_BAR; PG8_WAIT_L(0); PG8_MMA(0, 0, At, B0); PG8_BAR; PG8_SCHED;
            PG8_LDB(B1, 0, 1); PG8_STAGE(PG8_SB(0, 0), b2, voffB);
            PG8_BAR; PG8_WAIT_L(0); PG8_MMA(0, 1, At, B1); PG8_BAR;
            PG8_LDA(At, 0, 1); PG8_STAGE(PG8_SA(0, 0), a2, voffA);
            PG8_BAR; PG8_WAIT_L(0); PG8_MMA(1, 0, At, B0); PG8_BAR; PG8_SCHED;
            PG8_STAGE(PG8_SB(0, 1), b2 + hstep, voffB);
            PG8_WAIT_V(6); PG8_BAR; PG8_MMA(1, 1, At, B1); PG8_BAR;
            PG8_LDB(B0, 1, 0); PG8_SCHED; PG8_LDA(At, 1, 0); PG8_STAGE(PG8_SA(0, 1), a2 + hstep, voffA);
            PG8_WAIT_L(8); PG8_BAR; PG8_WAIT_L(0); PG8_MMA(0, 0, At, B0); PG8_BAR; PG8_SCHED;
            PG8_LDB(B1, 1, 1); PG8_STAGE(PG8_SB(1, 0), b3, voffB);
            PG8_BAR; PG8_WAIT_L(0); PG8_MMA(0, 1, At, B1); PG8_BAR;
            PG8_LDA(At, 1, 1); PG8_STAGE(PG8_SA(1, 0), a3, voffA);
            PG8_BAR; PG8_WAIT_L(0); PG8_MMA(1, 0, At, B0); PG8_BAR; PG8_SCHED;
            PG8_STAGE(PG8_SB(1, 1), b3 + hstep, voffB);
            PG8_WAIT_V(6); PG8_BAR; PG8_MMA(1, 1, At, B1); PG8_BAR;
        }
        PG8_STAMP();
        if constexpr (!Epi::AFTER_DRAIN) { E(acc, cur, wr, wc, fr, fq); S.done(cur); }
        PG8_STAMP();
        if (!has_next) break;
#pragma unroll
        for (int a = 0; a < 2; ++a)
#pragma unroll
            for (int b = 0; b < 2; ++b)
#pragma unroll
                for (int m = 0; m < 4; ++m)
#pragma unroll
                    for (int n = 0; n < 2; ++n) acc[a][b][m][n] = (f32x4){0.f, 0.f, 0.f, 0.f};
        cur = nxt; cA = nA; cB = nB; ++ui;
    }
    PG8_WAIT_V(0);
    if (wr == 0) PG8_BAR;
    PG8_BAR;
    if constexpr (Epi::AFTER_DRAIN) { E.fused(acc, cur, wr, wc, fr, fq, lds, wid, lane); S.done(cur); }
    PG8_STAMP();
    if (STAMP && wid == 0) { stamps[lane] = lane < nts ? (((unsigned long long)(unsigned)ts_hi << 32) | (unsigned)ts_lo) : 0ull;
        if (lane == 62) stamps[62] = rt_entry; if (lane == 63) stamps[63] = (unsigned long long)wall_clock64(); }
#undef PG8_STAMP
#undef PG8_SA
#undef PG8_SB
#undef PG8_STAGE
#undef PG8_LDA
#undef PG8_LDB
#undef PG8_MMA
#undef PG8_WAIT_V
#undef PG8_WAIT_L
#undef PG8_BAR
#undef PG8_SCHED
}
}

using pg8::bf16x8; using pg8::f32x4;
typedef unsigned short u16;
typedef unsigned u32x2 __attribute__((ext_vector_type(2)));
#define LAS __attribute__((address_space(3)))

#ifndef REP_ATTN
#define REP_ATTN 1
#endif
#ifndef REP_RET
#define REP_RET 1
#endif
#ifndef REP_G1
#define REP_G1 1
#endif
#ifndef REP_P0A
#define REP_P0A 1
#endif
constexpr int NTHREADS = 512;
constexpr int LDS_MAIN = 141312;
constexpr int LDS_BYTES = LDS_MAIN + 16;
constexpr float LOG2E = 1.4426950408889634f;
constexpr float ALPHA_F = 1.681792830507429f;

constexpr size_t OUT_NCK = 8388608, OUT_NCV = 16777216, OUT_NSF = 25165824, OUT_NSB = 33554432;
constexpr size_t WS_WT_A1 = 0, WS_WT_OA1 = 8388608, WS_WT_B = 10485760, WS_WT_OB = 23068672, WS_WT_C = 27262976, WS_WT_OC = 35651584,
                 WS_MOD = 37748736, WS_ROPE = 38010880, WS_ABUF = 38273024, WS_WT_A0 = 55050240, WS_WT_OA0 = 63438848, WS_UATT = 65536000;
constexpr size_t UA_Q = WS_UATT, UA_Z = WS_UATT + 16777216, UA_KC = WS_UATT + 33554432, UA_KL = WS_UATT + 41943040, UA_VTC = WS_UATT + 52428800, UA_VTL = WS_UATT + 60817408;
constexpr size_t UR_QR = WS_WT_A0, UR_KR = UR_QR + 16777216, UR_KTR = UR_QR + 33554432, UR_VTR = UR_QR + 50331648, UR_G = UR_QR + 83886080, UR_O = UR_QR + 117440512, UR_SB = UR_QR + 150994944;
constexpr size_t UC_T1 = WS_UATT, UC_PC = WS_UATT + 16777216;
constexpr size_t WS_BAR = UR_SB + 50331648;
constexpr size_t WS_NEEDED = WS_BAR + 16384;

struct Prm {
    const float* in[23];
    float* out;
    char* ws;
    float lam_init[2];
};

typedef const __attribute__((address_space(4))) Prm* KP;
__device__ __forceinline__ KP lp(KP k) { asm volatile("" : "+s"(k)); return k; }
__device__ __forceinline__ u16 f2bf(float f) { unsigned u = __float_as_uint(f); u += 0x7fffu + ((u >> 16) & 1u); return (u16)(u >> 16); }
__device__ __forceinline__ float bf2f(u16 h) { return __uint_as_float(((unsigned)h) << 16); }
__device__ __forceinline__ unsigned pk2(float lo, float hi) { unsigned r; asm("v_cvt_pk_bf16_f32 %0, %1, %2" : "=v"(r) : "v"(lo), "v"(hi)); return r; }
__device__ __forceinline__ u32x2 pk4(f32x4 v) { u32x2 r; r.x = pk2(v[0], v[1]); r.y = pk2(v[2], v[3]); return r; }
__device__ __forceinline__ float silu_f(float x) { return x / (1.0f + __expf(-x)); }
__device__ __forceinline__ float ex2(float x) { return __builtin_amdgcn_exp2f(x); }
__device__ __forceinline__ int tid_l() { int t = threadIdx.x; asm volatile("" : "+v"(t)); return t; }
__device__ __forceinline__ int row_n5(int r) { return r < 4096 ? 0 : 1 + ((r - 4096) >> 10); }
#define MFMA16(a, b, c) __builtin_amdgcn_mfma_f32_16x16x32_bf16((a), (b), (c), 0, 0, 0)


#define XB_TMO      128
#define XB_XCNT(j)  (256  + 64 * (j))
#define XB_XSUB(j)  (1280 + 64 * (j))
#define XB_XGEN(j)  (2304 + 64 * (j))
#define XB_TOP      3328
#define XB_TOPGEN   3392
#define XCD_BAR_WORDS 3456
#define XB_SPIN_CAP (1u << 18)
__device__ __forceinline__ unsigned xb_ld(unsigned* p)              { return __hip_atomic_load(p, __ATOMIC_RELAXED, __HIP_MEMORY_SCOPE_AGENT); }
__device__ __forceinline__ unsigned xb_add(unsigned* p, unsigned v) { return __hip_atomic_fetch_add(p, v, __ATOMIC_RELAXED, __HIP_MEMORY_SCOPE_AGENT); }
__device__ __forceinline__ unsigned xb_xcc_id() { return (unsigned)__builtin_amdgcn_s_getreg((3 << 11) | 20) & 0xFu; }
#define XB_SPIN(cond, bar) do { unsigned _sp = 0; while (cond) { __builtin_amdgcn_s_sleep(1); \
    if ((++_sp & 255u) == 0u) { if (xb_ld(&(bar)[XB_TMO])) break; if (_sp > XB_SPIN_CAP) { atomicAdd(&(bar)[XB_TMO], 1u); break; } } } } while (0)
struct XcdBarrier { unsigned* bar; unsigned x; volatile LAS unsigned* st; };
__device__ __forceinline__ XcdBarrier xcd_barrier_post(unsigned* bar, volatile LAS unsigned* st) {
    XcdBarrier b; b.bar = bar; b.x = xb_xcc_id(); b.st = st;
    if (threadIdx.x == 0) (void)xb_add(&bar[XB_XCNT(b.x)], 1u);
    return b;
}
__device__ __forceinline__ void xcd_barrier_complete(unsigned* bar, unsigned x, unsigned& nloc, unsigned& nx) {
    const unsigned G = gridDim.x * gridDim.y * gridDim.z;
    unsigned sum, cnt, mine, sp = 0u;
    for (;;) {
        sum = 0u; cnt = 0u; mine = 0u;
#pragma unroll
        for (unsigned j = 0; j < 16; ++j) { const unsigned c = xb_ld(&bar[XB_XCNT(j)]); sum += c; cnt += (c > 0u) ? 1u : 0u; mine = (j == x) ? c : mine; }
        if (sum == G) break;
        __builtin_amdgcn_s_sleep(1);
        if ((++sp & 255u) == 0u) { if (xb_ld(&bar[XB_TMO])) break; if (sp > XB_SPIN_CAP) { atomicAdd(&bar[XB_TMO], 1u); break; } }
    }
    nloc = mine > 0u ? mine : 1u; nx = cnt > 0u ? cnt : 1u;
}
__device__ __forceinline__ void xcd_barrier(const XcdBarrier& b) {
    asm volatile("s_waitcnt vmcnt(0)" ::: "memory");
    __syncthreads();
    if (threadIdx.x == 0) {
        unsigned* bar = b.bar;
        __builtin_amdgcn_s_waitcnt(0);
        unsigned nloc = b.st[0], nx = b.st[1];
        if (nloc == 0u) { xcd_barrier_complete(bar, b.x, nloc, nx); b.st[0] = nloc; b.st[1] = nx; }
        const unsigned old = xb_add(&bar[XB_XSUB(b.x)], 1u);
        const unsigned gen = old / nloc;
        if (old + 1u == (gen + 1u) * nloc) {
            __builtin_amdgcn_fence(__ATOMIC_RELEASE, "agent");
            asm volatile("s_waitcnt vmcnt(0)" ::: "memory");
            const unsigned og = xb_add(&bar[XB_TOP], 1u);
            const unsigned tg = og / nx;
            if (og + 1u == (tg + 1u) * nx) xb_add(&bar[XB_TOPGEN], 1u);
            else XB_SPIN(xb_ld(&bar[XB_TOPGEN]) == tg, bar);
            __builtin_amdgcn_fence(__ATOMIC_ACQUIRE, "agent");
            xb_add(&bar[XB_XGEN(b.x)], 1u);
            asm volatile("s_waitcnt vmcnt(0)" ::: "memory");
        } else {
            XB_SPIN(xb_ld(&bar[XB_XGEN(b.x)]) == gen, bar);
            __builtin_amdgcn_fence(__ATOMIC_ACQUIRE, "agent");
            asm volatile("s_waitcnt vmcnt(0)" ::: "memory");
        }
    }
    __syncthreads();
}

struct Epi {
    static constexpr bool PERM = false, AFTER_DRAIN = false;
    int kind; int layer; int j;
    KP p;
    __device__ __forceinline__ void operator()(const f32x4 (&acc)[2][2][4][2], const pg8::Unit& u, int wr, int wc, int fr, int fq) const {
        char* ws = p->ws;
        const int pm = u.pm, pn = u.pn;
        if (kind == 0) {
            const bool lat = pm >= 16;
            const int b = lat ? ((pm - 16) >> 2) : pm;
            const int t0 = lat ? (((pm - 16) & 3) << 8) : 0;
            if (pn < 8) {
                const bool isq = pn < 4;
                const int G = ((pn & 3) << 2) + wc, h = G >> 1, mm = G & 1;
                const float* rope = (const float*)(ws + WS_ROPE);
#pragma unroll
                for (int ai = 0; ai < 2; ++ai)
#pragma unroll
                    for (int m = 0; m < 4; ++m) {
                        const int rl = ai * 128 + wr * 64 + m * 16 + fr;
                        const int r = pm * 256 + rl, t = t0 + rl;
#pragma unroll
                        for (int n = 0; n < 2; ++n) {
                            const int dd = 16 * n + 4 * fq;
                            f32x4 x1 = acc[ai][0][m][n], x2 = acc[ai][1][m][n], o1, o2;
                            if (lat) {
                                const f32x4 cs0 = *(const f32x4*)(rope + ((size_t)t * 32 + dd) * 2), cs1 = *(const f32x4*)(rope + ((size_t)t * 32 + dd) * 2 + 4);
                                const float c0 = cs0[0], s0 = cs0[1], c1 = cs0[2], s1 = cs0[3], c2 = cs1[0], s2 = cs1[1], c3 = cs1[2], s3 = cs1[3];
                                o1[0] = x1[0] * c0 - x2[0] * s0; o2[0] = x1[0] * s0 + x2[0] * c0;
                                o1[1] = x1[1] * c1 - x2[1] * s1; o2[1] = x1[1] * s1 + x2[1] * c1;
                                o1[2] = x1[2] * c2 - x2[2] * s2; o2[2] = x1[2] * s2 + x2[2] * c2;
                                o1[3] = x1[3] * c3 - x2[3] * s3; o2[3] = x1[3] * s3 + x2[3] * c3;
                            } else { o1 = x1; o2 = x2; }
                            if (isq) {
                                u16* q = (u16*)(ws + UA_Q) + (size_t)r * 1024 + G * 64 + dd;
                                *(u32x2*)q = pk4(o1); *(u32x2*)(q + 32) = pk4(o2);
                            } else if (lat) {
                                u16* k = (u16*)(ws + UA_KL) + ((size_t)((b * 8 + h) * 2 + mm) * 1280 + t) * 64 + dd;
                                *(u32x2*)k = pk4(o1); *(u32x2*)(k + 32) = pk4(o2);
                            } else {
                                u16* k = (u16*)(ws + UA_KC) + ((size_t)((b * 8 + h) * 2 + mm) * 256 + t) * 64 + dd;
                                *(u32x2*)k = pk4(o1); *(u32x2*)(k + 32) = pk4(o2);
                                float* o = p->out + OUT_NCK + ((size_t)(b * 2 + j) * 256 + t) * 1024 + G * 64 + dd;
                                *(f32x4*)o = o1; *(f32x4*)(o + 32) = o2;
                            }
                        }
                    }
            } else if (pn < 12) {
#pragma unroll
                for (int ai = 0; ai < 2; ++ai)
#pragma unroll
                    for (int m = 0; m < 4; ++m) {
                        const int rl = ai * 128 + wr * 64 + m * 16 + fr;
                        const int t = t0 + rl;
#pragma unroll
                        for (int bj = 0; bj < 2; ++bj)
#pragma unroll
                            for (int n = 0; n < 2; ++n) {
                                const int c = (pn - 8) * 256 + bj * 128 + wc * 32 + n * 16 + 4 * fq;
                                const int h = c >> 7, dv = c & 127;
                                const f32x4 v = acc[ai][bj][m][n];
                                if (lat) {
                                    u16* vt = (u16*)(ws + UA_VTL) + ((size_t)(b * 8 + h) * 128 + dv) * 1280 + t;
                                    vt[0] = f2bf(v[0]); vt[1280] = f2bf(v[1]); vt[2560] = f2bf(v[2]); vt[3840] = f2bf(v[3]);
                                } else {
                                    u16* vt = (u16*)(ws + UA_VTC) + ((size_t)(b * 8 + h) * 128 + dv) * 256 + t;
                                    vt[0] = f2bf(v[0]); vt[256] = f2bf(v[1]); vt[512] = f2bf(v[2]); vt[768] = f2bf(v[3]);
                                    *(f32x4*)(p->out + OUT_NCV + ((size_t)(b * 2 + j) * 256 + t) * 1024 + c) = v;
                                }
                            }
                    }
            } else {
#pragma unroll
                for (int ai = 0; ai < 2; ++ai)
#pragma unroll
                    for (int m = 0; m < 4; ++m) {
                        const int r = pm * 256 + ai * 128 + wr * 64 + m * 16 + fr;
#pragma unroll
                        for (int bj = 0; bj < 2; ++bj)
#pragma unroll
                            for (int n = 0; n < 2; ++n) {
                                const int c = (pn - 12) * 256 + bj * 128 + wc * 32 + n * 16 + 4 * fq;
                                f32x4 v = acc[ai][bj][m][n];
                                v[0] = silu_f(v[0]); v[1] = silu_f(v[1]); v[2] = silu_f(v[2]); v[3] = silu_f(v[3]);
                                *(u32x2*)((u16*)(ws + UA_Z) + (size_t)r * 1024 + c) = pk4(v);
                            }
                    }
            }
        } else if (kind == 1) {
#pragma unroll
            for (int ai = 0; ai < 2; ++ai)
#pragma unroll
                for (int m = 0; m < 4; ++m) {
                    const int r = pm * 256 + ai * 128 + wr * 64 + m * 16 + fr;
#pragma unroll
                    for (int bj = 0; bj < 2; ++bj)
#pragma unroll
                        for (int n = 0; n < 2; ++n) {
                            const int cb = bj * 128 + wc * 32 + n * 16 + 4 * fq;
                            f32x4 v = acc[ai][bj][m][n];
                            if (pn < 4) {
                                *(u32x2*)((u16*)(ws + UR_QR) + (size_t)r * 1024 + pn * 256 + cb) = pk4(v);
                            } else if (pn < 8) {
                                const int c = (pn - 4) * 256 + cb;
                                v = v * 0.0625f;
                                *(u32x2*)((u16*)(ws + UR_KR) + (size_t)r * 1024 + c) = pk4(v);
                                u16* kt = (u16*)(ws + UR_KTR) + (size_t)c * 8192 + r;
                                kt[0] = f2bf(v[0]); kt[8192] = f2bf(v[1]); kt[16384] = f2bf(v[2]); kt[24576] = f2bf(v[3]);
                            } else if (pn < 16) {
                                const int c = (pn - 8) * 256 + cb;
                                u16* vt = (u16*)(ws + UR_VTR) + (size_t)c * 8192 + r;
                                vt[0] = f2bf(v[0]); vt[8192] = f2bf(v[1]); vt[16384] = f2bf(v[2]); vt[24576] = f2bf(v[3]);
                            } else {
                                const int c = (pn - 16) * 256 + cb;
                                v[0] = silu_f(v[0]); v[1] = silu_f(v[1]); v[2] = silu_f(v[2]); v[3] = silu_f(v[3]);
                                *(u32x2*)((u16*)(ws + UR_G) + (size_t)r * 2048 + c) = pk4(v);
                            }
                        }
                }
        } else if (kind == 2) {
#pragma unroll
            for (int ai = 0; ai < 2; ++ai)
#pragma unroll
                for (int m = 0; m < 4; ++m) {
                    const int r = pm * 256 + ai * 128 + wr * 64 + m * 16 + fr;
                    const int e = pn * 64 + wc * 16 + 4 * fq;
                    const f32x4 bg = acc[ai][0][m][0], cgv = acc[ai][0][m][1], uu = acc[ai][1][m][0], z = acc[ai][1][m][1];
                    f32x4 t1, pc;
#pragma unroll
                    for (int q = 0; q < 4; ++q) { t1[q] = bg[q] * silu_f(z[q]); pc[q] = cgv[q] * uu[q]; }
                    *(u32x2*)((u16*)(ws + UC_T1) + (size_t)r * 1024 + e) = pk4(t1);
                    *(u32x2*)((u16*)(ws + UC_PC) + (size_t)r * 1024 + e) = pk4(pc);
                }
        } else {
            const float* xin = (layer == 0) ? (pm < 16 ? p->in[0] : p->in[1] - (size_t)4096 * 1024) : p->out;
            const float* gate = (const float*)(ws + WS_MOD) + ((size_t)layer * 5 + (pm < 16 ? 0 : 1 + ((pm - 16) >> 2))) * 3072 + 2048;
#pragma unroll
            for (int ai = 0; ai < 2; ++ai)
#pragma unroll
                for (int m = 0; m < 4; ++m) {
                    const int r = pm * 256 + ai * 128 + wr * 64 + m * 16 + fr;
#pragma unroll
                    for (int bj = 0; bj < 2; ++bj)
#pragma unroll
                        for (int n = 0; n < 2; ++n) {
                            const int c = pn * 256 + bj * 128 + wc * 32 + n * 16 + 4 * fq;
                            const f32x4 xv = *(const f32x4*)(xin + (size_t)r * 1024 + c);
                            const f32x4 gv = *(const f32x4*)(gate + c);
                            *(f32x4*)(p->out + (size_t)r * 1024 + c) = xv * ALPHA_F + gv * acc[ai][bj][m][n];
                        }
                }
        }
    }
};

__device__ __forceinline__ int perm_col(int kind, int n) {
    if (kind == 1) {
        if (n >= 2048) return n;
        const int blk = n >> 8, w = n & 255, Gl = w >> 6, half = (w >> 5) & 1, dd = w & 31;
        return (blk << 8) + half * 128 + Gl * 32 + dd;
    } else if (kind == 2) {
        const int part = n >> 10, e = n & 1023, blk = e >> 6, el = e & 63, wc = el >> 4, f = el & 15;
        return blk * 256 + (part >> 1) * 128 + wc * 32 + (part & 1) * 16 + f;
    }
    return n;
}

__device__ __forceinline__ void phase_p0a(KP p, LAS unsigned char* lds) {
    const int tid = tid_l();
    LAS u16* sT = (LAS u16*)lds;
    LAS float* scond = (LAS float*)(lds + 36864);
    LAS float* red = (LAS float*)(lds + 36864 + 20480);
    for (int i = tid; i < 5120; i += NTHREADS) {
        const int n = i >> 10, k = i & 1023;
        const float v = (n == 0) ? p->in[7][k] : p->in[6][(n - 1) * 1024 + k];
        scond[i] = silu_f(v);
    }
    __syncthreads();
    for (int u = blockIdx.x; u < 192; u += gridDim.x) {
        const int i = u / 48, c0 = (u % 48) * 64;
        const int cg4 = (tid & 15) * 4, ks = tid >> 4;
        const float* w = p->in[8] + (size_t)i * 1024 * 3072 + (size_t)(ks * 32) * 3072 + c0 + cg4;
        f32x4 a0 = {0.f, 0.f, 0.f, 0.f}, a1 = a0, a2 = a0, a3 = a0, a4 = a0;
#pragma unroll 8
        for (int k = 0; k < 32; ++k) {
            const f32x4 wv = *(const f32x4*)(w + (size_t)k * 3072);
            const int kk = ks * 32 + k;
            a0 += wv * scond[kk]; a1 += wv * scond[1024 + kk]; a2 += wv * scond[2048 + kk]; a3 += wv * scond[3072 + kk]; a4 += wv * scond[4096 + kk];
        }
        *(LAS f32x4*)(red + (ks * 5 + 0) * 64 + cg4) = a0; *(LAS f32x4*)(red + (ks * 5 + 1) * 64 + cg4) = a1; *(LAS f32x4*)(red + (ks * 5 + 2) * 64 + cg4) = a2;
        *(LAS f32x4*)(red + (ks * 5 + 3) * 64 + cg4) = a3; *(LAS f32x4*)(red + (ks * 5 + 4) * 64 + cg4) = a4;
        __syncthreads();
        if (tid < 320) {
            const int n = tid >> 6, cc = tid & 63;
            float sacc = p->in[9][i * 3072 + c0 + cc];
#pragma unroll
            for (int q = 0; q < 32; ++q) sacc += red[(q * 5 + n) * 64 + cc];
            ((float*)(p->ws + WS_MOD))[((size_t)i * 5 + n) * 3072 + c0 + cc] = sacc;
        }
        __syncthreads();
    }
    for (int mi = 0; mi < 8; ++mi) {
        const float* W; size_t off; int K, N, kind;
        switch (mi) {
            case 0: W = p->in[12]; off = WS_WT_A0; K = 1024; N = 4096; kind = 1; break;
            case 1: W = p->in[12] + (size_t)1024 * 4096; off = WS_WT_A1; K = 1024; N = 4096; kind = 1; break;
            case 2: W = p->in[15]; off = WS_WT_OA0; K = 1024; N = 1024; kind = 0; break;
            case 3: W = p->in[15] + (size_t)1024 * 1024; off = WS_WT_OA1; K = 1024; N = 1024; kind = 0; break;
            case 4: W = p->in[16]; off = WS_WT_B; K = 1024; N = 6144; kind = 0; break;
            case 5: W = p->in[19]; off = WS_WT_OB; K = 2048; N = 1024; kind = 0; break;
            case 6: W = p->in[20]; off = WS_WT_C; K = 1024; N = 4096; kind = 2; break;
            default: W = p->in[22]; off = WS_WT_OC; K = 1024; N = 1024; kind = 0; break;
        }
        u16* WT = (u16*)(p->ws + off);
        const int ntn = N >> 8, ntiles = (K >> 6) * ntn;
        for (int tile = (int)gridDim.x - 1 - (int)blockIdx.x; tile < ntiles; tile += gridDim.x) {
            const int k0 = (tile / ntn) << 6, n0 = (tile % ntn) << 8;
            f32x4 v[8];
#pragma unroll
            for (int i = 0; i < 8; ++i) {
                const int row = (tid >> 4) + 32 * (i & 1), col4 = (i >> 1) * 64 + (tid & 15) * 4;
                v[i] = *(const f32x4*)(W + (size_t)(k0 + row) * N + n0 + col4);
            }
#pragma unroll
            for (int i = 0; i < 8; ++i) {
                const int row = (tid >> 4) + 32 * (i & 1), c4 = (tid & 15) * 4;
                LAS u16* t = sT + (i >> 1) * 4608;
                t[(c4 + 0) * 72 + row] = f2bf(v[i][0]); t[(c4 + 1) * 72 + row] = f2bf(v[i][1]);
                t[(c4 + 2) * 72 + row] = f2bf(v[i][2]); t[(c4 + 3) * 72 + row] = f2bf(v[i][3]);
            }
            __syncthreads();
            const int n = tid >> 3, ks = (tid & 7) * 8;
#pragma unroll
            for (int sub = 0; sub < 4; ++sub) {
                const bf16x8 o = *(const LAS bf16x8*)(sT + sub * 4608 + n * 72 + ks);
                *(bf16x8*)(WT + (size_t)perm_col(kind, n0 + sub * 64 + n) * K + k0 + ks) = o;
            }
            __syncthreads();
        }
    }
    for (int gt = (int)gridDim.x - 1 - (int)blockIdx.x; gt < 256; gt += gridDim.x) {
        const int mat = gt >> 3, t8 = gt & 7, k0 = (t8 >> 1) << 6, n0 = (t8 & 1) << 8;
        const float* W = ((mat >> 4) ? p->in[5] : p->in[4]) + (size_t)(mat & 15) * 131072;
        u16* WT = (u16*)(p->ws + UR_SB) + (size_t)mat * 131072;
        f32x4 v[8];
#pragma unroll
        for (int i = 0; i < 8; ++i) {
            const int row = (tid >> 4) + 32 * (i & 1), col4 = (i >> 1) * 64 + (tid & 15) * 4;
            v[i] = *(const f32x4*)(W + (size_t)(k0 + row) * 512 + n0 + col4);
        }
#pragma unroll
        for (int i = 0; i < 8; ++i) {
            const int row = (tid >> 4) + 32 * (i & 1), c4 = (tid & 15) * 4;
            LAS u16* t = sT + (i >> 1) * 4608;
            t[(c4 + 0) * 72 + row] = f2bf(v[i][0]); t[(c4 + 1) * 72 + row] = f2bf(v[i][1]);
            t[(c4 + 2) * 72 + row] = f2bf(v[i][2]); t[(c4 + 3) * 72 + row] = f2bf(v[i][3]);
        }
        __syncthreads();
        const int n = tid >> 3, ks = (tid & 7) * 8;
#pragma unroll
        for (int sub = 0; sub < 4; ++sub) {
            const bf16x8 o = *(const LAS bf16x8*)(sT + sub * 4608 + n * 72 + ks);
            *(bf16x8*)(WT + (size_t)(n0 + sub * 64 + n) * 256 + k0 + ks) = o;
        }
        __syncthreads();
    }
    for (int e = blockIdx.x * NTHREADS + tid; e < 32768; e += gridDim.x * NTHREADS) {
        const int t = e >> 5, dd = e & 31, f = dd & 15;
        const float inv = exp2f(-(float)f * (13.287712379549449f / 16.0f));
        const float pos = (dd < 16) ? (float)(t >> 6) : (float)(t & 63);
        const float ang = pos * inv;
        float* o = (float*)(p->ws + WS_ROPE) + (size_t)e * 2;
        o[0] = cosf(ang); o[1] = sinf(ang);
    }
}

__device__ __forceinline__ void cache_convert(KP p, int j) {
    const int gt = blockIdx.x * NTHREADS + tid_l(), gs = gridDim.x * NTHREADS;
    for (int idx = gt; idx < 4 * 256 * 8 * 16; idx += gs) {
        const int d8 = idx & 15, h = (idx >> 4) & 7, s = (idx >> 7) & 255, b = idx >> 15;
        const float* src = p->in[2] + ((size_t)((b * 2 + j) * 256 + s) * 8 + h) * 128 + d8 * 8;
        const f32x4 v0 = *(const f32x4*)src, v1 = *(const f32x4*)(src + 4);
        const int mm = d8 >> 3, d = (d8 & 7) * 8;
        u16* dst = (u16*)(p->ws + UA_KL) + ((size_t)((b * 8 + h) * 2 + mm) * 1280 + 1024 + s) * 64 + d;
        pg8::u32x4 o; o.x = pk2(v0[0], v0[1]); o.y = pk2(v0[2], v0[3]); o.z = pk2(v1[0], v1[1]); o.w = pk2(v1[2], v1[3]);
        *(pg8::u32x4*)dst = o;
    }
    for (int idx = gt; idx < 4 * 256 * 8 * 16; idx += gs) {
        const int s = idx & 255, d8 = (idx >> 8) & 15, h = (idx >> 12) & 7, b = idx >> 15;
        const float* src = p->in[3] + ((size_t)((b * 2 + j) * 256 + s) * 8 + h) * 128 + d8 * 8;
        const f32x4 v0 = *(const f32x4*)src, v1 = *(const f32x4*)(src + 4);
        u16* dst = (u16*)(p->ws + UA_VTL) + ((size_t)(b * 8 + h) * 128 + d8 * 8) * 1280 + 1024 + s;
        dst[0] = f2bf(v0[0]); dst[1280] = f2bf(v0[1]); dst[2560] = f2bf(v0[2]); dst[3840] = f2bf(v0[3]);
        dst[5120] = f2bf(v1[0]); dst[6400] = f2bf(v1[1]); dst[7680] = f2bf(v1[2]); dst[8960] = f2bf(v1[3]);
    }
}

__device__ __forceinline__ void phase_p0b(KP p) {
    const float* mod = (const float*)(p->ws + WS_MOD);
    u16* A = (u16*)(p->ws + WS_ABUF);
    for (int idx = blockIdx.x * NTHREADS + tid_l(); idx < 8192 * 128; idx += gridDim.x * NTHREADS) {
        const int r = idx >> 7, c = (idx & 127) * 8;
        const float* x = (r < 4096) ? p->in[0] + (size_t)r * 1024 + c : p->in[1] + (size_t)(r - 4096) * 1024 + c;
        const float* md = mod + (size_t)row_n5(r) * 3072;
        const f32x4 x0 = *(const f32x4*)x, x1 = *(const f32x4*)(x + 4);
        const f32x4 sh0 = *(const f32x4*)(md + c), sh1 = *(const f32x4*)(md + c + 4), sc0 = *(const f32x4*)(md + 1024 + c), sc1 = *(const f32x4*)(md + 1024 + c + 4);
        const f32x4 h0 = x0 * (sc0 + 1.0f) + sh0, h1 = x1 * (sc1 + 1.0f) + sh1;
        pg8::u32x4 o; o.x = pk2(h0[0], h0[1]); o.y = pk2(h0[2], h0[3]); o.z = pk2(h1[0], h1[1]); o.w = pk2(h1[2], h1[3]);
        *(pg8::u32x4*)(A + (size_t)r * 1024 + c) = o;
    }
}

__device__ __forceinline__ void phase_ln(KP p, int li, int nxt) {
    const int tid = tid_l(), w = tid >> 6, lane = tid & 63;
    const float* g = p->in[10] + li * 1024; const float* bb = p->in[11] + li * 1024;
    u16* A = (u16*)(p->ws + WS_ABUF);
    for (int r = blockIdx.x * 8 + w; r < 8192; r += gridDim.x * 8) {
        float* x = p->out + (size_t)r * 1024;
        f32x4 v[4];
        float s = 0.f;
#pragma unroll
        for (int q = 0; q < 4; ++q) { v[q] = *(const f32x4*)(x + q * 256 + lane * 4); s += v[q][0] + v[q][1] + v[q][2] + v[q][3]; }
#pragma unroll
        for (int o = 32; o; o >>= 1) s += __shfl_xor(s, o, 64);
        const float mu = s * (1.0f / 1024.0f);
        float ss = 0.f;
#pragma unroll
        for (int q = 0; q < 4; ++q) { v[q] = v[q] - mu; ss += v[q][0] * v[q][0] + v[q][1] * v[q][1] + v[q][2] * v[q][2] + v[q][3] * v[q][3]; }
#pragma unroll
        for (int o = 32; o; o >>= 1) ss += __shfl_xor(ss, o, 64);
        const float rstd = rsqrtf(ss * (1.0f / 1024.0f) + 1e-5f);
        const float* md = (const float*)(p->ws + WS_MOD) + ((size_t)(nxt < 4 ? nxt : 0) * 5 + row_n5(r)) * 3072;
#pragma unroll
        for (int q = 0; q < 4; ++q) {
            const int c = q * 256 + lane * 4;
            const f32x4 xn = v[q] * rstd * *(const f32x4*)(g + c) + *(const f32x4*)(bb + c);
            *(f32x4*)(x + c) = xn;
            if (nxt < 4) {
                const f32x4 h = xn * (*(const f32x4*)(md + 1024 + c) + 1.0f) + *(const f32x4*)(md + c);
                *(u32x2*)(A + (size_t)r * 1024 + c) = pk4(h);
            }
        }
    }
}

__device__ __forceinline__ void phase_attn(KP p, int j, LAS unsigned char* lds) {
    const int tid = tid_l(), w = tid >> 6, lane = tid & 63, lr = lane & 15, lq = lane >> 4;
    LAS u16* sm = (LAS u16*)lds;
    float la = p->in[13][j * 256 + lane] * p->in[13][j * 256 + 64 + lane], lb = p->in[13][j * 256 + 128 + lane] * p->in[13][j * 256 + 192 + lane];
#pragma unroll
    for (int o = 32; o; o >>= 1) { la += __shfl_xor(la, o, 64); lb += __shfl_xor(lb, o, 64); }
    const float lam_init = p->lam_init[j];
    const float lamv = __expf(la) - __expf(lb) + lam_init;
    const float* subln = p->in[14] + j * 128;
    const u16* Q = (const u16*)(p->ws + UA_Q);
    const u16* Z = (const u16*)(p->ws + UA_Z);
    u16* A = (u16*)(p->ws + WS_ABUF);
    const float SC = 0.125f * LOG2E;
    for (int it = blockIdx.x; it < 512; it += gridDim.x) {
        int b, h, r0, nkeys; const u16* Kb; const u16* Vb;
        if (it < 256) { b = it >> 6; h = (it >> 3) & 7; r0 = 4096 + b * 1024 + (it & 7) * 128; nkeys = 1280;
            Kb = (const u16*)(p->ws + UA_KL) + (size_t)(b * 8 + h) * 2 * 1280 * 64; Vb = (const u16*)(p->ws + UA_VTL) + (size_t)(b * 8 + h) * 128 * 1280; }
        else { const int i2 = it - 256; b = i2 >> 4; h = (i2 >> 1) & 7; r0 = b * 256 + (i2 & 1) * 128; nkeys = 256;
            Kb = (const u16*)(p->ws + UA_KC) + (size_t)(b * 8 + h) * 2 * 256 * 64; Vb = (const u16*)(p->ws + UA_VTC) + (size_t)(b * 8 + h) * 128 * 256; }
        const int row_a = r0 + w * 16 + lr;
        bf16x8 qf[2][2];
#pragma unroll
        for (int m = 0; m < 2; ++m)
#pragma unroll
            for (int ks = 0; ks < 2; ++ks) qf[m][ks] = *(const bf16x8*)(Q + (size_t)row_a * 1024 + h * 128 + m * 64 + ks * 32 + lq * 8);
        f32x4 O[2][8];
        float mrow[2], lsum[2];
#pragma unroll
        for (int m = 0; m < 2; ++m) {
#pragma unroll
            for (int n = 0; n < 8; ++n) O[m][n] = (f32x4){0.f, 0.f, 0.f, 0.f};
            mrow[m] = -1e30f; lsum[m] = 0.f;
        }
        const int ntiles = nkeys >> 6;
        const int krow = tid >> 3, kseg = (tid & 7) * 8, vrow = tid >> 2, vseg = (tid & 3) * 16;
        bf16x8 g0, g1, g2, g3;
        g0 = *(const bf16x8*)(Kb + (size_t)krow * 64 + kseg);
        g1 = *(const bf16x8*)(Kb + (size_t)(nkeys + krow) * 64 + kseg);
        g2 = *(const bf16x8*)(Vb + (size_t)vrow * nkeys + vseg);
        g3 = *(const bf16x8*)(Vb + (size_t)vrow * nkeys + vseg + 8);
        *(LAS bf16x8*)(sm + krow * 72 + kseg) = g0; *(LAS bf16x8*)(sm + 4608 + krow * 72 + kseg) = g1;
        *(LAS bf16x8*)(sm + 9216 + vrow * 72 + vseg) = g2; *(LAS bf16x8*)(sm + 9216 + vrow * 72 + vseg + 8) = g3;
        __syncthreads();
        for (int kt = 0; kt < ntiles; ++kt) {
            const int cur = kt & 1;
            const bool more = kt + 1 < ntiles;
            if (more) {
                const int k0 = (kt + 1) * 64;
                g0 = *(const bf16x8*)(Kb + (size_t)(k0 + krow) * 64 + kseg);
                g1 = *(const bf16x8*)(Kb + (size_t)(nkeys + k0 + krow) * 64 + kseg);
                g2 = *(const bf16x8*)(Vb + (size_t)vrow * nkeys + k0 + vseg);
                g3 = *(const bf16x8*)(Vb + (size_t)vrow * nkeys + k0 + vseg + 8);
            }
            const LAS u16* bK = sm + cur * 18432; const LAS u16* bV = bK + 9216;
            f32x4 s[2][4];
#pragma unroll
            for (int m = 0; m < 2; ++m)
#pragma unroll
                for (int n = 0; n < 4; ++n) s[m][n] = (f32x4){0.f, 0.f, 0.f, 0.f};
#pragma unroll
            for (int m = 0; m < 2; ++m)
#pragma unroll
                for (int ks = 0; ks < 2; ++ks)
#pragma unroll
                    for (int n = 0; n < 4; ++n) {
                        const bf16x8 kf = *(const LAS bf16x8*)(bK + m * 4608 + (n * 16 + lr) * 72 + ks * 32 + lq * 8);
                        s[m][n] = MFMA16(kf, qf[m][ks], s[m][n]);
                    }
            bf16x8 pf[2][2];
#pragma unroll
            for (int m = 0; m < 2; ++m) {
                float mx = -1e30f;
#pragma unroll
                for (int n = 0; n < 4; ++n)
#pragma unroll
                    for (int i = 0; i < 4; ++i) { s[m][n][i] *= SC; mx = fmaxf(mx, s[m][n][i]); }
                mx = fmaxf(mx, __shfl_xor(mx, 16, 64)); mx = fmaxf(mx, __shfl_xor(mx, 32, 64));
                const float mn = fmaxf(mrow[m], mx);
                const float al = ex2(mrow[m] - mn);
                mrow[m] = mn;
                if (__builtin_amdgcn_ballot_w64(al != 1.0f) != 0ull) {
#pragma unroll
                    for (int n = 0; n < 8; ++n) O[m][n] = O[m][n] * al;
                }
                float ls = 0.f;
#pragma unroll
                for (int n = 0; n < 4; ++n)
#pragma unroll
                    for (int i = 0; i < 4; ++i) { s[m][n][i] = ex2(s[m][n][i] - mn); ls += s[m][n][i]; }
                lsum[m] = lsum[m] * al + ls;
#pragma unroll
                for (int k2 = 0; k2 < 2; ++k2) {
                    pg8::u32x4 pk; pk.x = pk2(s[m][2 * k2][0], s[m][2 * k2][1]); pk.y = pk2(s[m][2 * k2][2], s[m][2 * k2][3]);
                    pk.z = pk2(s[m][2 * k2 + 1][0], s[m][2 * k2 + 1][1]); pk.w = pk2(s[m][2 * k2 + 1][2], s[m][2 * k2 + 1][3]);
                    pf[m][k2] = __builtin_bit_cast(bf16x8, pk);
                }
            }
#pragma unroll
            for (int k2 = 0; k2 < 2; ++k2)
#pragma unroll
                for (int n = 0; n < 8; ++n) {
                    const u32x2 va = *(const LAS u32x2*)(bV + (n * 16 + lr) * 72 + k2 * 32 + lq * 4);
                    const u32x2 vb = *(const LAS u32x2*)(bV + (n * 16 + lr) * 72 + k2 * 32 + 16 + lq * 4);
                    pg8::u32x4 vv; vv.x = va.x; vv.y = va.y; vv.z = vb.x; vv.w = vb.y;
                    const bf16x8 vf = __builtin_bit_cast(bf16x8, vv);
                    O[0][n] = MFMA16(vf, pf[0][k2], O[0][n]);
                    O[1][n] = MFMA16(vf, pf[1][k2], O[1][n]);
                }
            if (more) {
                LAS u16* nb = sm + (cur ^ 1) * 18432;
                *(LAS bf16x8*)(nb + krow * 72 + kseg) = g0; *(LAS bf16x8*)(nb + 4608 + krow * 72 + kseg) = g1;
                *(LAS bf16x8*)(nb + 9216 + vrow * 72 + vseg) = g2; *(LAS bf16x8*)(nb + 9216 + vrow * 72 + vseg + 8) = g3;
            }
            __syncthreads();
        }
        float l0 = lsum[0], l1 = lsum[1];
        l0 += __shfl_xor(l0, 16, 64); l0 += __shfl_xor(l0, 32, 64);
        l1 += __shfl_xor(l1, 16, 64); l1 += __shfl_xor(l1, 32, 64);
        const float i0 = 1.0f / l0, i1 = lamv / l1;
        float ss = 0.f;
#pragma unroll
        for (int n = 0; n < 8; ++n) {
            O[0][n] = O[0][n] * i0 - O[1][n] * i1;
            ss += O[0][n][0] * O[0][n][0] + O[0][n][1] * O[0][n][1] + O[0][n][2] * O[0][n][2] + O[0][n][3] * O[0][n][3];
        }
        ss += __shfl_xor(ss, 16, 64); ss += __shfl_xor(ss, 32, 64);
        const float rstd = rsqrtf(ss * (1.0f / 128.0f) + 1e-6f) * (1.0f - lam_init);
#pragma unroll
        for (int n = 0; n < 8; ++n) {
            const int dv = n * 16 + lq * 4;
            const size_t off = (size_t)row_a * 1024 + h * 128 + dv;
            const u32x2 zz = *(const u32x2*)(Z + off);
            const f32x4 sg = *(const f32x4*)(subln + dv);
            f32x4 o;
            o[0] = O[0][n][0] * rstd * sg[0] * bf2f((u16)(zz.x & 0xffffu)); o[1] = O[0][n][1] * rstd * sg[1] * bf2f((u16)(zz.x >> 16));
            o[2] = O[0][n][2] * rstd * sg[2] * bf2f((u16)(zz.y & 0xffffu)); o[3] = O[0][n][3] * rstd * sg[3] * bf2f((u16)(zz.y >> 16));
            *(u32x2*)(A + off) = pk4(o);
        }
    }
}

__device__ __forceinline__ void phase_ret(KP p, LAS unsigned char* lds) {
    const int tid = tid_l(), w = tid >> 6, lane = tid & 63, lr = lane & 15, lq = lane >> 4;
    LAS u16* sm = (LAS u16*)lds;
    const u16* QR = (const u16*)(p->ws + UR_QR); const u16* KR = (const u16*)(p->ws + UR_KR);
    const u16* KTR = (const u16*)(p->ws + UR_KTR); const u16* VTR = (const u16*)(p->ws + UR_VTR);
    const u16* S0T = (const u16*)(p->ws + UR_SB);
    u16* OB = (u16*)(p->ws + UR_O);
    for (int it = blockIdx.x; it < 512; it += gridDim.x) {
        const bool lat = it < 256;
        int b, h, qt, dvh, r0, T;
        if (lat) { b = it >> 6; h = (it >> 4) & 3; qt = (it >> 1) & 7; dvh = it & 1; r0 = 4096 + b * 1024; T = 1024; }
        else { const int i2 = it - 256; b = i2 >> 4; h = (i2 >> 2) & 3; qt = (i2 >> 1) & 1; dvh = i2 & 1; r0 = b * 256; T = 256; }
        const float lgf2 = log1pf(-expf(p->in[17][h])) * LOG2E, lgb2 = log1pf(-expf(p->in[18][h])) * LOG2E;
        const int nkey = T >> 6, nsteps = lat ? nkey + 8 : nkey;
        const int qpos = qt * 128 + w * 16 + lr;
        const size_t qrow = (size_t)(r0 + qpos);
        bf16x8 qf[8];
#pragma unroll
        for (int ks = 0; ks < 8; ++ks) qf[ks] = *(const bf16x8*)(QR + qrow * 1024 + h * 256 + ks * 32 + lq * 8);
        f32x4 O[16];
#pragma unroll
        for (int n = 0; n < 16; ++n) O[n] = (f32x4){0.f, 0.f, 0.f, 0.f};
        const u16* kbase = KR + (size_t)r0 * 1024 + h * 256;
        const u16* vbase = VTR + (size_t)(h * 512 + dvh * 256) * 8192 + r0;
        const u16* sbase = S0T + (size_t)(b * 4 + h) * 131072 + (size_t)(dvh * 256) * 256;
        bf16x8 gk[4], gv[4];
#define RET_ISSUE(st) do { int tvv = tid; asm volatile("" : "+v"(tvv)); \
            if ((st) < nkey) { \
                _Pragma("unroll") for (int k = 0; k < 4; ++k) { const int idx = tvv + k * 512; \
                    gk[k] = *(const bf16x8*)(kbase + (size_t)((st) * 64 + (idx >> 5)) * 1024 + (idx & 31) * 8); \
                    gv[k] = *(const bf16x8*)(vbase + (size_t)(idx >> 3) * 8192 + (st) * 64 + (idx & 7) * 8); } \
            } else { const int s2 = (st) - nkey; const u16* sb = sbase + (size_t)(s2 >> 2) * 16 * 131072 + (s2 & 3) * 64; \
                _Pragma("unroll") for (int k = 0; k < 4; ++k) { const int idx = tvv + k * 512; \
                    gv[k] = *(const bf16x8*)(sb + (size_t)(idx >> 3) * 256 + (idx & 7) * 8); } } } while (0)
#define RET_COMMIT(st, buf) do { LAS u16* bb = sm + (buf) * 35328; int tvv = tid; asm volatile("" : "+v"(tvv)); \
            if ((st) < nkey) { _Pragma("unroll") for (int k = 0; k < 4; ++k) { const int idx = tvv + k * 512; \
                    *(LAS bf16x8*)(bb + (idx >> 5) * 264 + (idx & 31) * 8) = gk[k]; } } \
            _Pragma("unroll") for (int k = 0; k < 4; ++k) { const int idx = tvv + k * 512; \
                    *(LAS bf16x8*)(bb + 16896 + (idx >> 3) * 72 + (idx & 7) * 8) = gv[k]; } } while (0)
        RET_ISSUE(0);
        __syncthreads();
        RET_COMMIT(0, 0);
        __syncthreads();
        for (int st = 0; st < nsteps; ++st) {
            const int cur = st & 1;
            const bool more = st + 1 < nsteps;
            if (more) RET_ISSUE(st + 1);
            const LAS u16* bK = sm + cur * 35328; const LAS u16* bV = bK + 16896;
            float lf = lgf2, lb = lgb2; int lqv = lq, qpv = qpos; asm volatile("" : "+v"(lf), "+v"(lb), "+v"(lqv), "+v"(qpv));
            if (st < nkey) {
                f32x4 s4[4];
#pragma unroll
                for (int n = 0; n < 4; ++n) s4[n] = (f32x4){0.f, 0.f, 0.f, 0.f};
#pragma unroll
                for (int ks = 0; ks < 8; ++ks)
#pragma unroll
                    for (int n = 0; n < 4; ++n) {
                        const bf16x8 kf = *(const LAS bf16x8*)(bK + (n * 16 + lr) * 264 + ks * 32 + lq * 8);
                        s4[n] = MFMA16(kf, qf[ks], s4[n]);
                    }
#pragma unroll
                for (int n = 0; n < 4; ++n)
#pragma unroll
                    for (int i = 0; i < 4; ++i) {
                        const int df = qpv - (st * 64 + n * 16 + lqv * 4 + i);
                        const float e = ex2((df > 0 ? lf : -lb) * (float)df);
                        s4[n][i] *= (df == 0) ? 2.0f : e;
                    }
#pragma unroll
                for (int k2 = 0; k2 < 2; ++k2) {
                    pg8::u32x4 pk; pk.x = pk2(s4[2 * k2][0], s4[2 * k2][1]); pk.y = pk2(s4[2 * k2][2], s4[2 * k2][3]);
                    pk.z = pk2(s4[2 * k2 + 1][0], s4[2 * k2 + 1][1]); pk.w = pk2(s4[2 * k2 + 1][2], s4[2 * k2 + 1][3]);
                    const bf16x8 pf = __builtin_bit_cast(bf16x8, pk);
#pragma unroll
                    for (int n = 0; n < 16; ++n) {
                        const u32x2 va = *(const LAS u32x2*)(bV + (n * 16 + lr) * 72 + k2 * 32 + lq * 4);
                        const u32x2 vb = *(const LAS u32x2*)(bV + (n * 16 + lr) * 72 + k2 * 32 + 16 + lq * 4);
                        pg8::u32x4 vv; vv.x = va.x; vv.y = va.y; vv.z = vb.x; vv.w = vb.y;
                        O[n] = MFMA16(__builtin_bit_cast(bf16x8, vv), pf, O[n]);
                    }
                }
            } else {
                const int s2 = st - nkey, dt = s2 & 3;
                const float qd = (s2 < 4) ? ex2(lf * (float)(qpv + 1)) : ex2(lb * (float)(T - qpv));
#pragma unroll
                for (int k2 = 0; k2 < 2; ++k2) {
                    bf16x8 qsrc = qf[0];
#pragma unroll
                    for (int ks = 0; ks < 8; ++ks) if (ks == dt * 2 + k2) qsrc = qf[ks];
                    const pg8::u32x4 qu = __builtin_bit_cast(pg8::u32x4, qsrc);
                    pg8::u32x4 qo;
                    qo.x = pk2(__uint_as_float(qu.x << 16) * qd, __uint_as_float(qu.x & 0xffff0000u) * qd);
                    qo.y = pk2(__uint_as_float(qu.y << 16) * qd, __uint_as_float(qu.y & 0xffff0000u) * qd);
                    qo.z = pk2(__uint_as_float(qu.z << 16) * qd, __uint_as_float(qu.z & 0xffff0000u) * qd);
                    qo.w = pk2(__uint_as_float(qu.w << 16) * qd, __uint_as_float(qu.w & 0xffff0000u) * qd);
                    const bf16x8 qs = __builtin_bit_cast(bf16x8, qo);
#pragma unroll
                    for (int n = 0; n < 16; ++n) {
                        const bf16x8 sf = *(const LAS bf16x8*)(bV + (n * 16 + lr) * 72 + k2 * 32 + lq * 8);
                        O[n] = MFMA16(sf, qs, O[n]);
                    }
                }
            }
            if (more) RET_COMMIT(st + 1, cur ^ 1);
            __syncthreads();
        }
#pragma unroll
        for (int n = 0; n < 16; ++n)
            *(u32x2*)(OB + qrow * 2048 + h * 512 + dvh * 256 + n * 16 + lq * 4) = pk4(O[n]);
    }
#undef RET_ISSUE
#undef RET_COMMIT
    for (int it = blockIdx.x; it < 512; it += gridDim.x) {
        const int b = it >> 5, h = (it >> 3) & 3, ds = it & 7, r0 = b * 256;
        const float lgf2 = log1pf(-expf(p->in[17][h])) * LOG2E, lgb2 = log1pf(-expf(p->in[18][h])) * LOG2E;
        LAS u16* vF = sm; LAS u16* vB = sm + 16896;
        int tv = tid; asm volatile("" : "+v"(tv));
        __syncthreads();
#pragma unroll 1
        for (int k = 0; k < 4; ++k) {
            const int idx = tv + k * 512, row = idx >> 5, seg = idx & 31;
            const bf16x8 v = *(const bf16x8*)(VTR + (size_t)(h * 512 + ds * 64 + row) * 8192 + r0 + seg * 8);
            const pg8::u32x4 vu = __builtin_bit_cast(pg8::u32x4, v);
            float f[8];
            f[0] = __uint_as_float(vu.x << 16); f[1] = __uint_as_float(vu.x & 0xffff0000u); f[2] = __uint_as_float(vu.y << 16); f[3] = __uint_as_float(vu.y & 0xffff0000u);
            f[4] = __uint_as_float(vu.z << 16); f[5] = __uint_as_float(vu.z & 0xffff0000u); f[6] = __uint_as_float(vu.w << 16); f[7] = __uint_as_float(vu.w & 0xffff0000u);
            pg8::u32x4 of, ob;
            float df[8], db[8];
#pragma unroll
            for (int q = 0; q < 8; ++q) { const int m = seg * 8 + q; df[q] = f[q] * ex2(lgf2 * (float)(255 - m)); db[q] = f[q] * ex2(lgb2 * (float)m); }
            of.x = pk2(df[0], df[1]); of.y = pk2(df[2], df[3]); of.z = pk2(df[4], df[5]); of.w = pk2(df[6], df[7]);
            ob.x = pk2(db[0], db[1]); ob.y = pk2(db[2], db[3]); ob.z = pk2(db[4], db[5]); ob.w = pk2(db[6], db[7]);
            *(LAS pg8::u32x4*)(vF + row * 264 + seg * 8) = of;
            *(LAS pg8::u32x4*)(vB + row * 264 + seg * 8) = ob;
        }
        __syncthreads();
        f32x4 SF[4][2], SBk[4][2];
#pragma unroll
        for (int n = 0; n < 4; ++n)
#pragma unroll
            for (int c = 0; c < 2; ++c) { SF[n][c] = (f32x4){0.f, 0.f, 0.f, 0.f}; SBk[n][c] = (f32x4){0.f, 0.f, 0.f, 0.f}; }
        const u16* ktw = KTR + (size_t)(h * 256 + w * 32 + lr) * 8192 + r0 + lq * 8;
#pragma unroll
        for (int half = 0; half < 2; ++half) {
            bf16x8 kf[4][2];
#pragma unroll
            for (int k4 = 0; k4 < 4; ++k4)
#pragma unroll
                for (int c = 0; c < 2; ++c) kf[k4][c] = *(const bf16x8*)(ktw + (size_t)c * 16 * 8192 + (half * 4 + k4) * 32);
#pragma unroll
            for (int k4 = 0; k4 < 4; ++k4)
#pragma unroll
                for (int n = 0; n < 4; ++n) {
                    const bf16x8 a = *(const LAS bf16x8*)(vF + (n * 16 + lr) * 264 + (half * 4 + k4) * 32 + lq * 8);
                    const bf16x8 bb = *(const LAS bf16x8*)(vB + (n * 16 + lr) * 264 + (half * 4 + k4) * 32 + lq * 8);
#pragma unroll
                    for (int c = 0; c < 2; ++c) { SF[n][c] = MFMA16(a, kf[k4][c], SF[n][c]); SBk[n][c] = MFMA16(bb, kf[k4][c], SBk[n][c]); }
                }
        }
        const size_t st_off = (size_t)(b * 4 + h) * 131072 + ds * 64;
#pragma unroll
        for (int n = 0; n < 4; ++n)
#pragma unroll
            for (int c = 0; c < 2; ++c) {
                const size_t o = st_off + (size_t)(w * 32 + c * 16 + lr) * 512 + n * 16 + lq * 4;
                *(f32x4*)(p->out + OUT_NSF + o) = SF[n][c];
                *(f32x4*)(p->out + OUT_NSB + o) = SBk[n][c];
            }
    }
}

__device__ __forceinline__ void phase_retfin(KP p) {
    const int tid = tid_l(), w = tid >> 6, lane = tid & 63;
    const u16* OB = (const u16*)(p->ws + UR_O); const u16* Gb = (const u16*)(p->ws + UR_G);
    u16* A2 = (u16*)(p->ws + UR_QR);
    for (int rh = blockIdx.x * 8 + w; rh < 8192 * 4; rh += gridDim.x * 8) {
        const size_t off = (size_t)(rh >> 2) * 2048 + (rh & 3) * 512 + lane * 8;
        const bf16x8 o = *(const bf16x8*)(OB + off), g = *(const bf16x8*)(Gb + off);
        float of[8]; float ss = 0.f;
#pragma unroll
        for (int q = 0; q < 8; ++q) { of[q] = bf2f((u16)o[q]); ss += of[q] * of[q]; }
#pragma unroll
        for (int s = 32; s; s >>= 1) ss += __shfl_xor(ss, s, 64);
        const float rstd = rsqrtf(ss * (1.0f / 512.0f) + 1e-6f);
        bf16x8 a;
#pragma unroll
        for (int q = 0; q < 8; ++q) a[q] = (short)f2bf(of[q] * rstd * bf2f((u16)g[q]));
        *(bf16x8*)(A2 + off) = a;
    }
}

__device__ __forceinline__ void phase_convfin(KP p) {
    const u16* T1 = (const u16*)(p->ws + UC_T1); const u16* PC = (const u16*)(p->ws + UC_PC);
    u16* A = (u16*)(p->ws + WS_ABUF);
    const float* cw = p->in[21];
    for (int idx = blockIdx.x * NTHREADS + tid_l(); idx < 8192 * 128; idx += gridDim.x * NTHREADS) {
        const int r = idx >> 7, e = (idx & 127) * 8;
        const int t = r < 4096 ? (r & 255) : (r & 1023), T = r < 4096 ? 256 : 1024;
        const size_t off = (size_t)r * 1024 + e;
        const bf16x8 t1 = *(const bf16x8*)(T1 + off), pc = *(const bf16x8*)(PC + off);
        bf16x8 pp, pn;
#pragma unroll
        for (int q = 0; q < 8; ++q) { pp[q] = 0; pn[q] = 0; }
        if (t > 0) pp = *(const bf16x8*)(PC + off - 1024);
        if (t < T - 1) pn = *(const bf16x8*)(PC + off + 1024);
        bf16x8 a;
#pragma unroll
        for (int q = 0; q < 8; ++q) {
            const float cv = cw[e + q] * bf2f((u16)pp[q]) + cw[1024 + e + q] * bf2f((u16)pc[q]) + cw[2048 + e + q] * bf2f((u16)pn[q]);
            a[q] = (short)f2bf(bf2f((u16)t1[q]) * cv);
        }
        *(bf16x8*)(A + off) = a;
    }
}

__global__ void __launch_bounds__(512) mega(Prm p_unused) {
    const KP kp = (KP)__builtin_amdgcn_kernarg_segment_ptr();
    extern __shared__ __attribute__((aligned(16))) unsigned char shm[];
    LAS unsigned char* lds = (LAS unsigned char*)shm;
    cg::grid_group grid = cg::this_grid();
    pg8::StaticOrder S;
    volatile LAS unsigned* xst = (volatile LAS unsigned*)(lds + LDS_MAIN);
    if (threadIdx.x == 0) { xst[0] = 0u; xst[1] = 0u; xst[2] = 0u; xst[3] = 0u; }
    __syncthreads();
    XcdBarrier xb = xcd_barrier_post((unsigned*)(kp->ws + WS_BAR), xst);
#pragma nounroll
    for (int rep = 0; rep < REP_P0A; ++rep) phase_p0a(lp(kp), lds);
    grid.sync();
    phase_p0b(lp(kp));
    cache_convert(lp(kp), 0);
    xcd_barrier(xb);
    for (int li = 0; li < 4; ++li) {
        const int kind = li % 3, j = li / 3;
        const KP p = lp(kp);
        {
            pg8::Gemm g; g.A = (const u16*)(p->ws + WS_ABUF); g.M = 8192; g.K = 1024;
            if (kind == 0) { g.Bt = (const u16*)(p->ws + (j == 0 ? WS_WT_A0 : WS_WT_A1)); g.N = 4096; }
            else if (kind == 1) { g.Bt = (const u16*)(p->ws + WS_WT_B); g.N = 6144; }
            else { g.Bt = (const u16*)(p->ws + WS_WT_C); g.N = 4096; }
            Epi E; E.kind = kind; E.layer = li; E.j = j; E.p = lp(kp);
            S.init(g.M, g.N, (int)gridDim.x, (int)blockIdx.x);
#pragma nounroll
            for (int rep = 0; rep < REP_G1; ++rep) pg8::gemm_phase<Epi, pg8::StaticOrder, false>(lds, g, S, E, nullptr);
        }
        xcd_barrier(xb);
        if (kind == 0) {
#pragma nounroll
            for (int rep = 0; rep < REP_ATTN; ++rep) phase_attn(lp(kp), j, lds); }
        else if (kind == 1) {
#pragma nounroll
            for (int rep = 0; rep < REP_RET; ++rep) phase_ret(lp(kp), lds);
            xcd_barrier(xb); phase_retfin(lp(kp)); }
        else { phase_convfin(lp(kp)); }
        xcd_barrier(xb);
        {
            pg8::Gemm g; g.M = 8192; g.N = 1024;
            if (kind == 0) { g.A = (const u16*)(p->ws + WS_ABUF); g.Bt = (const u16*)(p->ws + (j == 0 ? WS_WT_OA0 : WS_WT_OA1)); g.K = 1024; }
            else if (kind == 1) { g.A = (const u16*)(p->ws + UR_QR); g.Bt = (const u16*)(p->ws + WS_WT_OB); g.K = 2048; }
            else { g.A = (const u16*)(p->ws + WS_ABUF); g.Bt = (const u16*)(p->ws + WS_WT_OC); g.K = 1024; }
            Epi E; E.kind = 3; E.layer = li; E.j = j; E.p = lp(kp);
            S.init(g.M, g.N, (int)gridDim.x, (int)blockIdx.x);
            pg8::gemm_phase<Epi, pg8::StaticOrder, false>(lds, g, S, E, nullptr);
        }
        xcd_barrier(xb);
        phase_ln(lp(kp), li, li + 1);
        if (li == 2) cache_convert(lp(kp), 1);
        xcd_barrier(xb);
    }
}

extern "C" void kernel_launch(void* const* d_in, const int* in_sizes, int n_in, void* d_out, int out_size, void* d_ws, size_t ws_size, hipStream_t stream) {
    static int grid_blocks = 0;
    if (!grid_blocks) {
        int dev = 0, cus = 0, per_cu = 0;
        hipGetDevice(&dev);
        hipDeviceGetAttribute(&cus, hipDeviceAttributeMultiprocessorCount, dev);
        hipFuncSetAttribute((const void*)mega, hipFuncAttributeMaxDynamicSharedMemorySize, LDS_BYTES);
        hipOccupancyMaxActiveBlocksPerMultiprocessor(&per_cu, mega, NTHREADS, LDS_BYTES);
        if (per_cu < 1) per_cu = 1;
        if (per_cu > 1) per_cu = 1;
        grid_blocks = cus * per_cu;
        if (ws_size < WS_NEEDED) fprintf(stderr, "workspace too small: %zu < %zu\n", ws_size, (size_t)WS_NEEDED);
    }
    Prm p{};
    for (int i = 0; i < 23; ++i) p.in[i] = (const float*)d_in[i];
    p.out = (float*)d_out;
    p.ws = (char*)d_ws;
    p.lam_init[0] = (float)(0.8 - 0.6 * exp(-0.3 * 0.0));
    p.lam_init[1] = (float)(0.8 - 0.6 * exp(-0.3 * 3.0));
    hipMemsetAsync((char*)d_ws + WS_BAR, 0, 16384, stream);
    void* args[] = {&p};
    hipError_t e = hipLaunchCooperativeKernel((void*)mega, dim3(grid_blocks), dim3(NTHREADS), args, LDS_BYTES, stream);
    if (e != hipSuccess) fprintf(stderr, "cooperative launch failed: %s (grid %d)\n", hipGetErrorString(e), grid_blocks);
}
```

```cpp
#include <hip/hip_runtime.h>
#include <hip/hip_cooperative_groups.h>
#include <cstdio>
#include <cmath>
namespace cg = cooperative_groups;

namespace pg8 {
#define PG8_LAS __attribute__((address_space(3)))
typedef unsigned short bf16_t;
typedef short bf16x8 __attribute__((ext_vector_type(8)));
typedef float f32x4 __attribute__((ext_vector_type(4)));
typedef unsigned u32x4 __attribute__((ext_vector_type(4)));
constexpr int BM = 256, BK = 64, HALF = 128, HTB = HALF * BK * 2  , STAGE_BYTES = 8 * HTB, NXCD = 8, WGM = 8;
__host__ __device__ __forceinline__ int lds_byte(int r, int c) { const int st = (r >> 4) * 2 + (c >> 5), rr = r & 15, cc = c & 31, ob = rr * 64 + cc * 2; return st * 1024 + (ob ^ (((ob >> 9) & 1) << 5)); }
__host__ __device__ __forceinline__ void stage_rc(int b, int& R, int& C) { const int st = b / 1024, sb = b % 1024, swz = sb ^ (((sb >> 9) & 1) << 5); R = (st >> 1) * 16 + swz / 64; C = (st & 1) * 32 + (swz % 64) / 2; }
__host__ __device__ __forceinline__ int perm32(int rho) { const int n = rho >> 4, i = rho & 15; return 8 * (i >> 2) + 4 * n + (i & 3); }

struct Unit { int pm, pn, kh; };
struct Gemm { const bf16_t* A; const bf16_t* Bt; int M, N, K, KL; };

struct StaticOrder {
    int nM, nN, nwg, G, c, nsplit;
    __host__ __device__ void init(int M, int N, int G_, int c_, int ns = 1) { nM = M / BM; nN = N / BM; nwg = nM * nN; G = G_; c = c_; nsplit = ns; }
    __host__ __device__ bool next(int i, Unit& u) const {
        const long L = (long)i * G + c; if (L >= (long)nwg * nsplit) return false;
        int wgid = (int)(L % nwg); u.kh = (int)(L / nwg); { const int q = nwg / NXCD, r = nwg % NXCD, xcd = wgid % NXCD, off = wgid / NXCD; wgid = (xcd < r ? xcd * (q + 1) : r * (q + 1) + (xcd - r) * q) + off; }
        const int nig = WGM * nN, gid = wgid / nig, fm = gid * WGM, gsz = (nM - fm) < WGM ? (nM - fm) : WGM;
        u.pm = fm + ((wgid % nig) % gsz); u.pn = (wgid % nig) / gsz; return true;
    }
    __device__ __forceinline__ void a_ready(const Unit&) const {}
    __device__ __forceinline__ void done(const Unit&) const {}
};
template <class Epi, class Sched, bool STAMP = false>
__device__ __forceinline__ void gemm_phase(PG8_LAS unsigned char* lds, const Gemm g, const Sched& S, const Epi& E, unsigned long long* stamps) {
    int tid_ = threadIdx.x; asm volatile("" : "+v"(tid_)); const int tid = tid_, wid = __builtin_amdgcn_readfirstlane(tid >> 6), lane = tid & 63, wr = wid >> 2, wc = wid & 3, fr = lane & 15, fq = lane >> 4;
    const int K = g.K, nt = g.KL / BK;
    int ts_lo = 0, ts_hi = 0, nts = 0; const unsigned long long rt_entry = STAMP ? (unsigned long long)wall_clock64() : 0ull;
#define PG8_STAMP() do { if (STAMP && wid == 0 && nts < 64) { const unsigned long long _c = (unsigned long long)clock64(); \
        ts_lo = (lane == nts) ? (int)(unsigned)_c : ts_lo; ts_hi = (lane == nts) ? (int)(unsigned)(_c >> 32) : ts_hi; ++nts; } } while (0)
    PG8_STAMP();
    unsigned voffA[2], voffB[2];
#pragma unroll
    for (int i = 0; i < 2; ++i) { int R, C; stage_rc(tid * 16 + i * 8192, R, C); const int Rb = Epi::PERM ? ((R & ~31) + perm32(R & 31)) : R;
        voffA[i] = (unsigned)(R * K + C) * 2u; voffB[i] = (unsigned)(Rb * K + C) * 2u; }
    const size_t kstep = (size_t)(BK * 2);
    const size_t hstep = (size_t)HALF * K * 2;
    const size_t tstep = 2 * hstep;
    const unsigned ldsw = (unsigned)wid * 1024u;
    const int aoff = lds_byte(wr * 64 + fr, fq * 8), boff = lds_byte(wc * 32 + fr, fq * 8);
#define PG8_SA(b, h) (((b) * 2 + (h)) * HTB)
#define PG8_SB(b, h) ((4 + (b) * 2 + (h)) * HTB)
#define PG8_STAGE(bufoff, gbase, voff) do { _Pragma("unroll") for (int _i = 0; _i < 2; ++_i) \
        __builtin_amdgcn_global_load_lds((const unsigned*)((const char*)(gbase) + (voff)[_i]), (PG8_LAS unsigned*)(lds + (bufoff) + ldsw + _i * 8192), 16, 0, 0); } while (0)
#define PG8_LDA(dst, b, h) do { _Pragma("unroll") for (int m = 0; m < 4; ++m) _Pragma("unroll") for (int k = 0; k < 2; ++k) dst[m][k] = *(const PG8_LAS bf16x8*)(lds + PG8_SA(b, h) + aoff + m * 2048 + k * 1024); } while (0)
#define PG8_LDB(dst, b, h) do { _Pragma("unroll") for (int n = 0; n < 2; ++n) _Pragma("unroll") for (int k = 0; k < 2; ++k) dst[n][k] = *(const PG8_LAS bf16x8*)(lds + PG8_SB(b, h) + boff + n * 2048 + k * 1024); } while (0)
#define PG8_MMA(ai, bj, At, Bt) do { __builtin_amdgcn_s_setprio(1); _Pragma("unroll") for (int m = 0; m < 4; ++m) _Pragma("unroll") for (int n = 0; n < 2; ++n) _Pragma("unroll") for (int k = 0; k < 2; ++k) \
        acc[ai][bj][m][n] = __builtin_amdgcn_mfma_f32_16x16x32_bf16(Bt[n][k], At[m][k], acc[ai][bj][m][n], 0, 0, 0); __builtin_amdgcn_s_setprio(0); } while (0)
#define PG8_WAIT_V(n) asm volatile("s_waitcnt vmcnt(" #n ")" ::: "memory")
#define PG8_WAIT_L(n) asm volatile("s_waitcnt lgkmcnt(" #n ")" ::: "memory")
#define PG8_BAR __builtin_amdgcn_s_barrier()
#define PG8_SCHED __builtin_amdgcn_sched_barrier(0)
    Unit cur, nxt; int ui = 0;
    if (!S.next(0, cur)) return;
    f32x4 acc[2][2][4][2];
#pragma unroll
    for (int a = 0; a < 2; ++a)
#pragma unroll
        for (int b = 0; b < 2; ++b)
#pragma unroll
            for (int m = 0; m < 4; ++m)
#pragma unroll
                for (int n = 0; n < 2; ++n) acc[a][b][m][n] = (f32x4){0.f, 0.f, 0.f, 0.f};
    bf16x8 At[4][2], B0[2][2], B1[2][2];
    const char* cA = (const char*)g.A + (size_t)cur.pm * tstep + (size_t)cur.kh * g.KL * 2; const char* cB = (const char*)g.Bt + (size_t)cur.pn * tstep + (size_t)cur.kh * g.KL * 2;
    S.a_ready(cur);
    PG8_STAGE(PG8_SB(0, 0), cB, voffB); PG8_STAGE(PG8_SA(0, 0), cA, voffA); PG8_STAGE(PG8_SB(0, 1), cB + hstep, voffB); PG8_STAGE(PG8_SA(0, 1), cA + hstep, voffA);
    if (wr == 1) PG8_BAR;
    PG8_WAIT_V(4); PG8_BAR;
    PG8_STAGE(PG8_SB(1, 0), cB + kstep, voffB); PG8_STAGE(PG8_SA(1, 0), cA + kstep, voffA); PG8_STAGE(PG8_SB(1, 1), cB + hstep + kstep, voffB);
    PG8_WAIT_V(6); PG8_BAR;
    PG8_STAMP();
    for (;;) {
        const bool has_next = S.next(ui + 1, nxt);
        const char* nA = has_next ? (const char*)g.A + (size_t)nxt.pm * tstep + (size_t)nxt.kh * g.KL * 2 : cA; const char* nB = has_next ? (const char*)g.Bt + (size_t)nxt.pn * tstep + (size_t)nxt.kh * g.KL * 2 : cB;
        for (int t = 0; t < nt; t += 2) {
            const bool last = (t == nt - 2);
            const char* a1 = cA + (size_t)(t + 1) * kstep;
            const char* a2 = last ? nA : cA + (size_t)(t + 2) * kstep; const char* b2 = last ? nB : cB + (size_t)(t + 2) * kstep;
            const char* a3 = a2 + kstep; const char* b3 = b2 + kstep;
            if (last && has_next) S.a_ready(nxt);
            PG8_LDB(B0, 0, 0); PG8_SCHED; PG8_LDA(At, 0, 0); PG8_STAGE(PG8_SA(1, 1), a1 + hstep, voffA);
            PG8_WAIT_L(8); PG8_BAR; PG8_WAIT_L(0); PG8_MMA(0, 0, At, B0); PG8_BAR; PG8_SCHED;
            PG8_LDB(B1, 0, 1); PG8_STAGE(PG8_SB(0, 0), b2, voffB);
            PG8_BAR; PG8_WAIT_L(0); PG8_MMA(0, 1, At, B1); PG8_BAR;
            PG8_LDA(At, 0, 1); PG8_STAGE(PG8_SA(0, 0), a2, voffA);
            PG8_BAR; PG8_WAIT_L(0); PG8_MMA(1, 0, At, B0); PG8_BAR; PG8_SCHED;
            PG8_STAGE(PG8_SB(0, 1), b2 + hstep, voffB);
            PG8_WAIT_V(6); PG8_BAR; PG8_MMA(1, 1, At, B1); PG8_BAR;
            PG8_LDB(B0, 1, 0); PG8_SCHED; PG8_LDA(At, 1, 0); PG8_STAGE(PG8_SA(0, 1), a2 + hstep, voffA);
            PG8_WAIT_L(8); PG8_BAR; PG8_WAIT_L(0); PG8_MMA(0, 0, At, B0); PG8_BAR; PG8_SCHED;
            PG8_LDB(B1, 1, 1); PG8_STAGE(PG8_SB(1, 0), b3, voffB);
            PG8_BAR; PG8_WAIT_L(0); PG8_MMA(0, 1, At, B1); PG8_BAR;
            PG8_LDA(At, 1, 1); PG8_STAGE(PG8_SA(1, 0), a3, voffA);
            PG8_BAR; PG8_WAIT_L(0); PG8_MMA(1, 0, At, B0); PG8_BAR; PG8_SCHED;
            PG8_STAGE(PG8_SB(1, 1), b3 + hstep, voffB);
            PG8_WAIT_V(6); PG8_BAR; PG8_MMA(1, 1, At, B1); PG8_BAR;
        }
        PG8_STAMP();
        if constexpr (!Epi::AFTER_DRAIN) {
#ifdef REP_EPI
            _Pragma("nounroll") for (int _rep = 0; _rep < (E.kind != 3 ? 2 : 1); ++_rep)
#endif
            E(acc, cur, wr, wc, fr, fq);
            S.done(cur); }
        PG8_STAMP();
        if (!has_next) break;
#pragma unroll
        for (int a = 0; a < 2; ++a)
#pragma unroll
            for (int b = 0; b < 2; ++b)
#pragma unroll
                for (int m = 0; m < 4; ++m)
#pragma unroll
                    for (int n = 0; n < 2; ++n) acc[a][b][m][n] = (f32x4){0.f, 0.f, 0.f, 0.f};
        cur = nxt; cA = nA; cB = nB; ++ui;
    }
    PG8_WAIT_V(0);
    if (wr == 0) PG8_BAR;
    PG8_BAR;
    if constexpr (Epi::AFTER_DRAIN) { E.fused(acc, cur, wr, wc, fr, fq, lds, wid, lane); S.done(cur); }
    PG8_STAMP();
    if (STAMP && wid == 0) { stamps[lane] = lane < nts ? (((unsigned long long)(unsigned)ts_hi << 32) | (unsigned)ts_lo) : 0ull;
        if (lane == 62) stamps[62] = rt_entry; if (lane == 63) stamps[63] = (unsigned long long)wall_clock64(); }
#undef PG8_STAMP
#undef PG8_SA
#undef PG8_SB
#undef PG8_STAGE
#undef PG8_LDA
#undef PG8_LDB
#undef PG8_MMA
#undef PG8_WAIT_V
#undef PG8_WAIT_L
#undef PG8_BAR
#undef PG8_SCHED
}
}

using pg8::bf16x8; using pg8::f32x4;
typedef unsigned short u16;
typedef unsigned u32x2 __attribute__((ext_vector_type(2)));
#define LAS __attribute__((address_space(3)))

#ifndef REP_ATTN
#define REP_ATTN 1
#endif
#ifndef REP_RET
#define REP_RET 1
#endif
#ifndef REP_G1
#define REP_G1 1
#endif
#ifndef REP_P0A
#define REP_P0A 1
#endif
#ifndef REP_G2L0
#define REP_G2L0 1
#endif
#ifndef REP_LN
#define REP_LN 0
#endif
#ifndef REP_BAR
#define REP_BAR 1
#endif
#ifndef REP_EW
#define REP_EW 1
#endif
constexpr int NTHREADS = 512;
constexpr int LDS_MAIN = 141312;
constexpr int LDS_BYTES = LDS_MAIN + 16;
constexpr float LOG2E = 1.4426950408889634f;
constexpr float ALPHA_F = 1.681792830507429f;

constexpr size_t OUT_NCK = 8388608, OUT_NCV = 16777216, OUT_NSF = 25165824, OUT_NSB = 33554432;
constexpr size_t WS_WT_A1 = 0, WS_WT_OA1 = 8388608, WS_WT_B = 10485760, WS_WT_OB = 23068672, WS_WT_C = 27262976, WS_WT_OC = 35651584,
                 WS_MOD = 37748736, WS_ROPE = 38010880, WS_ABUF = 38273024, WS_WT_A0 = 55050240, WS_WT_OA0 = 63438848, WS_UATT = 65536000;
constexpr size_t UA_Q = WS_UATT, UA_Z = WS_UATT + 16777216, UA_KC = WS_UATT + 33554432, UA_KL = WS_UATT + 41943040, UA_VTC = WS_UATT + 52428800, UA_VTL = WS_UATT + 60817408;
constexpr size_t UR_QR = WS_WT_A0, UR_KR = UR_QR + 16777216, UR_KTR = UR_QR + 33554432, UR_VTR = UR_QR + 50331648, UR_G = UR_QR + 83886080, UR_O = UR_QR + 117440512, UR_SB = UR_QR + 150994944;
constexpr size_t UC_T1 = WS_UATT, UC_PC = WS_UATT + 16777216;
constexpr size_t WS_X2 = UR_SB + 8388608;
constexpr size_t WS_BAR = UR_SB + 50331648;
constexpr size_t WS_NEEDED = WS_BAR + 16384;

struct Prm {
    const float* in[23];
    float* out;
    char* ws;
    float lam_init[2];
};

typedef const __attribute__((address_space(4))) Prm* KP;
__device__ __forceinline__ KP lp(KP k) { asm volatile("" : "+s"(k)); return k; }
__device__ __forceinline__ u16 f2bf(float f) { unsigned u = __float_as_uint(f); u += 0x7fffu + ((u >> 16) & 1u); return (u16)(u >> 16); }
__device__ __forceinline__ float bf2f(u16 h) { return __uint_as_float(((unsigned)h) << 16); }
__device__ __forceinline__ unsigned pk2(float lo, float hi) { unsigned r; asm("v_cvt_pk_bf16_f32 %0, %1, %2" : "=v"(r) : "v"(lo), "v"(hi)); return r; }
__device__ __forceinline__ u32x2 pk4(f32x4 v) { u32x2 r; r.x = pk2(v[0], v[1]); r.y = pk2(v[2], v[3]); return r; }
__device__ __forceinline__ float silu_f(float x) { return x * __builtin_amdgcn_rcpf(1.0f + __builtin_amdgcn_exp2f(-x * 1.4426950408889634f)); }
__device__ __forceinline__ float ex2(float x) { return __builtin_amdgcn_exp2f(x); }
__device__ __forceinline__ int tid_l() { int t = threadIdx.x; asm volatile("" : "+v"(t)); return t; }
__device__ __forceinline__ int row_n5(int r) { return r < 4096 ? 0 : 1 + ((r - 4096) >> 10); }
#define MFMA16(a, b, c) __builtin_amdgcn_mfma_f32_16x16x32_bf16((a), (b), (c), 0, 0, 0)


#define XB_TMO      128
#define XB_XCNT(j)  (256  + 64 * (j))
#define XB_XSUB(j)  (1280 + 64 * (j))
#define XB_XGEN(j)  (2304 + 64 * (j))
#define XB_TOP      3328
#define XB_TOPGEN   3392
#define XCD_BAR_WORDS 3456
#define XB_SPIN_CAP (1u << 18)
__device__ __forceinline__ unsigned xb_ld(unsigned* p)              { return __hip_atomic_load(p, __ATOMIC_RELAXED, __HIP_MEMORY_SCOPE_AGENT); }
__device__ __forceinline__ unsigned xb_add(unsigned* p, unsigned v) { return __hip_atomic_fetch_add(p, v, __ATOMIC_RELAXED, __HIP_MEMORY_SCOPE_AGENT); }
__device__ __forceinline__ unsigned xb_xcc_id() { return (unsigned)__builtin_amdgcn_s_getreg((3 << 11) | 20) & 0xFu; }
#define XB_SPIN(cond, bar) do { unsigned _sp = 0; while (cond) { __builtin_amdgcn_s_sleep(1); \
    if ((++_sp & 255u) == 0u) { if (xb_ld(&(bar)[XB_TMO])) break; if (_sp > XB_SPIN_CAP) { atomicAdd(&(bar)[XB_TMO], 1u); break; } } } } while (0)
struct XcdBarrier { unsigned* bar; unsigned x; volatile LAS unsigned* st; };
__device__ __forceinline__ XcdBarrier xcd_barrier_post(unsigned* bar, volatile LAS unsigned* st) {
    XcdBarrier b; b.bar = bar; b.x = xb_xcc_id(); b.st = st;
    if (threadIdx.x == 0) (void)xb_add(&bar[XB_XCNT(b.x)], 1u);
    return b;
}
__device__ __forceinline__ void xcd_barrier_complete(unsigned* bar, unsigned x, unsigned& nloc, unsigned& nx) {
    const unsigned G = gridDim.x * gridDim.y * gridDim.z;
    unsigned sum, cnt, mine, sp = 0u;
    for (;;) {
        sum = 0u; cnt = 0u; mine = 0u;
#pragma unroll
        for (unsigned j = 0; j < 16; ++j) { const unsigned c = xb_ld(&bar[XB_XCNT(j)]); sum += c; cnt += (c > 0u) ? 1u : 0u; mine = (j == x) ? c : mine; }
        if (sum == G) break;
        __builtin_amdgcn_s_sleep(1);
        if ((++sp & 255u) == 0u) { if (xb_ld(&bar[XB_TMO])) break; if (sp > XB_SPIN_CAP) { atomicAdd(&bar[XB_TMO], 1u); break; } }
    }
    nloc = mine > 0u ? mine : 1u; nx = cnt > 0u ? cnt : 1u;
}
__device__ __forceinline__ void xcd_barrier(const XcdBarrier& b) {
    asm volatile("s_waitcnt vmcnt(0)" ::: "memory");
    __syncthreads();
    if (threadIdx.x == 0) {
        unsigned* bar = b.bar;
        __builtin_amdgcn_s_waitcnt(0);
        unsigned nloc = b.st[0], nx = b.st[1];
        if (nloc == 0u) { xcd_barrier_complete(bar, b.x, nloc, nx); b.st[0] = nloc; b.st[1] = nx; }
        const unsigned old = xb_add(&bar[XB_XSUB(b.x)], 1u);
        const unsigned gen = old / nloc;
        if (old + 1u == (gen + 1u) * nloc) {
            __builtin_amdgcn_fence(__ATOMIC_RELEASE, "agent");
            asm volatile("s_waitcnt vmcnt(0)" ::: "memory");
            const unsigned og = xb_add(&bar[XB_TOP], 1u);
            const unsigned tg = og / nx;
            if (og + 1u == (tg + 1u) * nx) xb_add(&bar[XB_TOPGEN], 1u);
            else XB_SPIN(xb_ld(&bar[XB_TOPGEN]) == tg, bar);
            __builtin_amdgcn_fence(__ATOMIC_ACQUIRE, "agent");
            xb_add(&bar[XB_XGEN(b.x)], 1u);
            asm volatile("s_waitcnt vmcnt(0)" ::: "memory");
        } else {
            XB_SPIN(xb_ld(&bar[XB_XGEN(b.x)]) == gen, bar);
            __builtin_amdgcn_fence(__ATOMIC_ACQUIRE, "agent");
            asm volatile("s_waitcnt vmcnt(0)" ::: "memory");
        }
    }
    __syncthreads();
}

struct Epi {
    static constexpr bool PERM = false, AFTER_DRAIN = false;
    int kind; int layer; int j;
    KP p;
    __device__ __forceinline__ void operator()(const f32x4 (&acc)[2][2][4][2], const pg8::Unit& u, int wr, int wc, int fr, int fq) const {
        char* ws = p->ws;
        const int pm = u.pm, pn = u.pn;
        if (kind == 0) {
            const bool lat = pm >= 16;
            const int b = lat ? ((pm - 16) >> 2) : pm;
            const int t0 = lat ? (((pm - 16) & 3) << 8) : 0;
            if (pn < 8) {
                const bool isq = pn < 4;
                const int G = ((pn & 3) << 2) + wc, h = G >> 1, mm = G & 1;
                const float* rope = (const float*)(ws + WS_ROPE);
#pragma unroll
                for (int ai = 0; ai < 2; ++ai)
#pragma unroll
                    for (int m = 0; m < 4; ++m) {
                        const int rl = ai * 128 + wr * 64 + m * 16 + fr;
                        const int r = pm * 256 + rl, t = t0 + rl;
#pragma unroll
                        for (int n = 0; n < 2; ++n) {
                            const int dd = 16 * n + 4 * fq;
                            f32x4 x1 = acc[ai][0][m][n], x2 = acc[ai][1][m][n], o1, o2;
                            if (lat) {
                                const f32x4 cs0 = *(const f32x4*)(rope + ((size_t)t * 32 + dd) * 2), cs1 = *(const f32x4*)(rope + ((size_t)t * 32 + dd) * 2 + 4);
                                const float c0 = cs0[0], s0 = cs0[1], c1 = cs0[2], s1 = cs0[3], c2 = cs1[0], s2 = cs1[1], c3 = cs1[2], s3 = cs1[3];
                                o1[0] = x1[0] * c0 - x2[0] * s0; o2[0] = x1[0] * s0 + x2[0] * c0;
                                o1[1] = x1[1] * c1 - x2[1] * s1; o2[1] = x1[1] * s1 + x2[1] * c1;
                                o1[2] = x1[2] * c2 - x2[2] * s2; o2[2] = x1[2] * s2 + x2[2] * c2;
                                o1[3] = x1[3] * c3 - x2[3] * s3; o2[3] = x1[3] * s3 + x2[3] * c3;
                            } else { o1 = x1; o2 = x2; }
                            if (isq) {
                                u16* q = (u16*)(ws + UA_Q) + (size_t)r * 1024 + G * 64 + dd;
                                *(u32x2*)q = pk4(o1); *(u32x2*)(q + 32) = pk4(o2);
                            } else if (lat) {
                                u16* k = (u16*)(ws + UA_KL) + ((size_t)((b * 8 + h) * 2 + mm) * 1280 + t) * 64 + dd;
                                *(u32x2*)k = pk4(o1); *(u32x2*)(k + 32) = pk4(o2);
                            } else {
                                u16* k = (u16*)(ws + UA_KC) + ((size_t)((b * 8 + h) * 2 + mm) * 256 + t) * 64 + dd;
                                *(u32x2*)k = pk4(o1); *(u32x2*)(k + 32) = pk4(o2);
                                float* o = p->out + OUT_NCK + ((size_t)(b * 2 + j) * 256 + t) * 1024 + G * 64 + dd;
                                *(f32x4*)o = o1; *(f32x4*)(o + 32) = o2;
                            }
                        }
                    }
            } else if (pn < 12) {
#pragma unroll
                for (int ai = 0; ai < 2; ++ai)
#pragma unroll
                    for (int m = 0; m < 4; ++m) {
                        const int rl = ai * 128 + wr * 64 + m * 16 + fr;
                        const int t = t0 + rl;
#pragma unroll
                        for (int bj = 0; bj < 2; ++bj)
#pragma unroll
                            for (int n = 0; n < 2; ++n) {
                                const int c = (pn - 8) * 256 + bj * 128 + wc * 32 + n * 16 + 4 * fq;
                                const int h = c >> 7, dv = c & 127;
                                const f32x4 v = acc[ai][bj][m][n];
                                if (lat) {
                                    u16* vt = (u16*)(ws + UA_VTL) + ((size_t)(b * 8 + h) * 128 + dv) * 1280 + t;
                                    vt[0] = f2bf(v[0]); vt[1280] = f2bf(v[1]); vt[2560] = f2bf(v[2]); vt[3840] = f2bf(v[3]);
                                } else {
                                    u16* vt = (u16*)(ws + UA_VTC) + ((size_t)(b * 8 + h) * 128 + dv) * 256 + t;
                                    vt[0] = f2bf(v[0]); vt[256] = f2bf(v[1]); vt[512] = f2bf(v[2]); vt[768] = f2bf(v[3]);
                                    *(f32x4*)(p->out + OUT_NCV + ((size_t)(b * 2 + j) * 256 + t) * 1024 + c) = v;
                                }
                            }
                    }
            } else {
#pragma unroll
                for (int ai = 0; ai < 2; ++ai)
#pragma unroll
                    for (int m = 0; m < 4; ++m) {
                        const int r = pm * 256 + ai * 128 + wr * 64 + m * 16 + fr;
#pragma unroll
                        for (int bj = 0; bj < 2; ++bj)
#pragma unroll
                            for (int n = 0; n < 2; ++n) {
                                const int c = (pn - 12) * 256 + bj * 128 + wc * 32 + n * 16 + 4 * fq;
                                f32x4 v = acc[ai][bj][m][n];
                                v[0] = silu_f(v[0]); v[1] = silu_f(v[1]); v[2] = silu_f(v[2]); v[3] = silu_f(v[3]);
                                *(u32x2*)((u16*)(ws + UA_Z) + (size_t)r * 1024 + c) = pk4(v);
                            }
                    }
            }
        } else if (kind == 1) {
#pragma unroll
            for (int ai = 0; ai < 2; ++ai)
#pragma unroll
                for (int m = 0; m < 4; ++m) {
                    const int r = pm * 256 + ai * 128 + wr * 64 + m * 16 + fr;
#pragma unroll
                    for (int bj = 0; bj < 2; ++bj)
#pragma unroll
                        for (int n = 0; n < 2; ++n) {
                            const int cb = bj * 128 + wc * 32 + n * 16 + 4 * fq;
                            f32x4 v = acc[ai][bj][m][n];
                            if (pn < 4) {
                                *(u32x2*)((u16*)(ws + UR_QR) + (size_t)r * 1024 + pn * 256 + cb) = pk4(v);
                            } else if (pn < 8) {
                                const int c = (pn - 4) * 256 + cb;
                                v = v * 0.0625f;
                                *(u32x2*)((u16*)(ws + UR_KR) + (size_t)r * 1024 + c) = pk4(v);
                                u16* kt = (u16*)(ws + UR_KTR) + (size_t)c * 8192 + r;
                                kt[0] = f2bf(v[0]); kt[8192] = f2bf(v[1]); kt[16384] = f2bf(v[2]); kt[24576] = f2bf(v[3]);
                            } else if (pn < 16) {
                                const int c = (pn - 8) * 256 + cb;
                                u16* vt = (u16*)(ws + UR_VTR) + (size_t)c * 8192 + r;
                                vt[0] = f2bf(v[0]); vt[8192] = f2bf(v[1]); vt[16384] = f2bf(v[2]); vt[24576] = f2bf(v[3]);
                            } else {
                                const int c = (pn - 16) * 256 + cb;
                                v[0] = silu_f(v[0]); v[1] = silu_f(v[1]); v[2] = silu_f(v[2]); v[3] = silu_f(v[3]);
                                *(u32x2*)((u16*)(ws + UR_G) + (size_t)r * 2048 + c) = pk4(v);
                            }
                        }
                }
        } else if (kind == 2) {
#pragma unroll
            for (int ai = 0; ai < 2; ++ai)
#pragma unroll
                for (int m = 0; m < 4; ++m) {
                    const int r = pm * 256 + ai * 128 + wr * 64 + m * 16 + fr;
                    const int e = pn * 64 + wc * 16 + 4 * fq;
                    const f32x4 bg = acc[ai][0][m][0], cgv = acc[ai][0][m][1], uu = acc[ai][1][m][0], z = acc[ai][1][m][1];
                    f32x4 t1, pc;
#pragma unroll
                    for (int q = 0; q < 4; ++q) { t1[q] = bg[q] * silu_f(z[q]); pc[q] = cgv[q] * uu[q]; }
                    *(u32x2*)((u16*)(ws + UC_T1) + (size_t)r * 1024 + e) = pk4(t1);
                    *(u32x2*)((u16*)(ws + UC_PC) + (size_t)r * 1024 + e) = pk4(pc);
                }
        } else {
            const float* xin = (layer == 0) ? (pm < 16 ? p->in[0] : p->in[1] - (size_t)4096 * 1024) : p->out;
            const float* gate = (const float*)(ws + WS_MOD) + ((size_t)layer * 5 + (pm < 16 ? 0 : 1 + ((pm - 16) >> 2))) * 3072 + 2048;
#pragma unroll
            for (int ai = 0; ai < 2; ++ai)
#pragma unroll
                for (int m = 0; m < 4; ++m) {
                    const int r = pm * 256 + ai * 128 + wr * 64 + m * 16 + fr;
#pragma unroll
                    for (int bj = 0; bj < 2; ++bj)
#pragma unroll
                        for (int n = 0; n < 2; ++n) {
                            const int c = pn * 256 + bj * 128 + wc * 32 + n * 16 + 4 * fq;
                            const f32x4 gv = *(const f32x4*)(gate + c);
                            if (u.kh == 0) {
                                const f32x4 xv = *(const f32x4*)(xin + (size_t)r * 1024 + c);
                                *(f32x4*)(p->out + (size_t)r * 1024 + c) = xv * ALPHA_F + gv * acc[ai][bj][m][n];
                            } else {
                                *(f32x4*)((float*)(ws + WS_X2) + (size_t)r * 1024 + c) = gv * acc[ai][bj][m][n];
                            }
                        }
                }
        }
    }
};

__device__ __forceinline__ int perm_col(int kind, int n) {
    if (kind == 1) {
        if (n >= 2048) return n;
        const int blk = n >> 8, w = n & 255, Gl = w >> 6, half = (w >> 5) & 1, dd = w & 31;
        return (blk << 8) + half * 128 + Gl * 32 + dd;
    } else if (kind == 2) {
        const int part = n >> 10, e = n & 1023, blk = e >> 6, el = e & 63, wc = el >> 4, f = el & 15;
        return blk * 256 + (part >> 1) * 128 + wc * 32 + (part & 1) * 16 + f;
    }
    return n;
}

__device__ __forceinline__ void phase_p0a(KP p, LAS unsigned char* lds) {
    const int tid = tid_l();
    LAS u16* sT = (LAS u16*)lds;
    LAS float* scond = (LAS float*)(lds + 36864);
    LAS float* red = (LAS float*)(lds + 36864 + 20480);
    for (int i = tid; i < 5120; i += NTHREADS) {
        const int n = i >> 10, k = i & 1023;
        const float v = (n == 0) ? p->in[7][k] : p->in[6][(n - 1) * 1024 + k];
        scond[i] = silu_f(v);
    }
    __syncthreads();
    for (int u = blockIdx.x; u < 192; u += gridDim.x) {
        const int i = u / 48, c0 = (u % 48) * 64;
        const int cg4 = (tid & 15) * 4, ks = tid >> 4;
        const float* w = p->in[8] + (size_t)i * 1024 * 3072 + (size_t)(ks * 32) * 3072 + c0 + cg4;
        f32x4 a0 = {0.f, 0.f, 0.f, 0.f}, a1 = a0, a2 = a0, a3 = a0, a4 = a0;
#pragma unroll 8
        for (int k = 0; k < 32; ++k) {
            const f32x4 wv = *(const f32x4*)(w + (size_t)k * 3072);
            const int kk = ks * 32 + k;
            a0 += wv * scond[kk]; a1 += wv * scond[1024 + kk]; a2 += wv * scond[2048 + kk]; a3 += wv * scond[3072 + kk]; a4 += wv * scond[4096 + kk];
        }
        *(LAS f32x4*)(red + (ks * 5 + 0) * 64 + cg4) = a0; *(LAS f32x4*)(red + (ks * 5 + 1) * 64 + cg4) = a1; *(LAS f32x4*)(red + (ks * 5 + 2) * 64 + cg4) = a2;
        *(LAS f32x4*)(red + (ks * 5 + 3) * 64 + cg4) = a3; *(LAS f32x4*)(red + (ks * 5 + 4) * 64 + cg4) = a4;
        __syncthreads();
        if (tid < 320) {
            const int n = tid >> 6, cc = tid & 63;
            float sacc = p->in[9][i * 3072 + c0 + cc];
#pragma unroll
            for (int q = 0; q < 32; ++q) sacc += red[(q * 5 + n) * 64 + cc];
            ((float*)(p->ws + WS_MOD))[((size_t)i * 5 + n) * 3072 + c0 + cc] = sacc;
        }
        __syncthreads();
    }
    for (int mi = 0; mi < 8; ++mi) {
        const float* W; size_t off; int K, N, kind;
        switch (mi) {
            case 0: W = p->in[12]; off = WS_WT_A0; K = 1024; N = 4096; kind = 1; break;
            case 1: W = p->in[12] + (size_t)1024 * 4096; off = WS_WT_A1; K = 1024; N = 4096; kind = 1; break;
            case 2: W = p->in[15]; off = WS_WT_OA0; K = 1024; N = 1024; kind = 0; break;
            case 3: W = p->in[15] + (size_t)1024 * 1024; off = WS_WT_OA1; K = 1024; N = 1024; kind = 0; break;
            case 4: W = p->in[16]; off = WS_WT_B; K = 1024; N = 6144; kind = 0; break;
            case 5: W = p->in[19]; off = WS_WT_OB; K = 2048; N = 1024; kind = 0; break;
            case 6: W = p->in[20]; off = WS_WT_C; K = 1024; N = 4096; kind = 2; break;
            default: W = p->in[22]; off = WS_WT_OC; K = 1024; N = 1024; kind = 0; break;
        }
        u16* WT = (u16*)(p->ws + off);
        const int ntn = N >> 8, ntiles = (K >> 6) * ntn;
        for (int tile = (int)gridDim.x - 1 - (int)blockIdx.x; tile < ntiles; tile += gridDim.x) {
            const int k0 = (tile / ntn) << 6, n0 = (tile % ntn) << 8;
            f32x4 v[8];
#pragma unroll
            for (int i = 0; i < 8; ++i) {
                const int row = (tid >> 4) + 32 * (i & 1), col4 = (i >> 1) * 64 + (tid & 15) * 4;
                v[i] = *(const f32x4*)(W + (size_t)(k0 + row) * N + n0 + col4);
            }
#pragma unroll
            for (int i = 0; i < 8; ++i) {
                const int row = (tid >> 4) + 32 * (i & 1), c4 = (tid & 15) * 4;
                LAS u16* t = sT + (i >> 1) * 4608;
                t[(c4 + 0) * 72 + row] = f2bf(v[i][0]); t[(c4 + 1) * 72 + row] = f2bf(v[i][1]);
                t[(c4 + 2) * 72 + row] = f2bf(v[i][2]); t[(c4 + 3) * 72 + row] = f2bf(v[i][3]);
            }
            __syncthreads();
            const int n = tid >> 3, ks = (tid & 7) * 8;
#pragma unroll
            for (int sub = 0; sub < 4; ++sub) {
                const bf16x8 o = *(const LAS bf16x8*)(sT + sub * 4608 + n * 72 + ks);
                *(bf16x8*)(WT + (size_t)perm_col(kind, n0 + sub * 64 + n) * K + k0 + ks) = o;
            }
            __syncthreads();
        }
    }
    for (int gt = (int)gridDim.x - 1 - (int)blockIdx.x; gt < 256; gt += gridDim.x) {
        const int mat = gt >> 3, t8 = gt & 7, k0 = (t8 >> 1) << 6, n0 = (t8 & 1) << 8;
        const float* W = ((mat >> 4) ? p->in[5] : p->in[4]) + (size_t)(mat & 15) * 131072;
        u16* WT = (u16*)(p->ws + UR_SB) + (size_t)mat * 131072;
        f32x4 v[8];
#pragma unroll
        for (int i = 0; i < 8; ++i) {
            const int row = (tid >> 4) + 32 * (i & 1), col4 = (i >> 1) * 64 + (tid & 15) * 4;
            v[i] = *(const f32x4*)(W + (size_t)(k0 + row) * 512 + n0 + col4);
        }
#pragma unroll
        for (int i = 0; i < 8; ++i) {
            const int row = (tid >> 4) + 32 * (i & 1), c4 = (tid & 15) * 4;
            LAS u16* t = sT + (i >> 1) * 4608;
            t[(c4 + 0) * 72 + row] = f2bf(v[i][0]); t[(c4 + 1) * 72 + row] = f2bf(v[i][1]);
            t[(c4 + 2) * 72 + row] = f2bf(v[i][2]); t[(c4 + 3) * 72 + row] = f2bf(v[i][3]);
        }
        __syncthreads();
        const int n = tid >> 3, ks = (tid & 7) * 8;
#pragma unroll
        for (int sub = 0; sub < 4; ++sub) {
            const bf16x8 o = *(const LAS bf16x8*)(sT + sub * 4608 + n * 72 + ks);
            *(bf16x8*)(WT + (size_t)(n0 + sub * 64 + n) * 256 + k0 + ks) = o;
        }
        __syncthreads();
    }
    for (int e = blockIdx.x * NTHREADS + tid; e < 32768; e += gridDim.x * NTHREADS) {
        const int t = e >> 5, dd = e & 31, f = dd & 15;
        const float inv = exp2f(-(float)f * (13.287712379549449f / 16.0f));
        const float pos = (dd < 16) ? (float)(t >> 6) : (float)(t & 63);
        const float ang = pos * inv;
        float* o = (float*)(p->ws + WS_ROPE) + (size_t)e * 2;
        o[0] = cosf(ang); o[1] = sinf(ang);
    }
}

__device__ __forceinline__ void cache_convert(KP p, int j) {
    const int gt = blockIdx.x * NTHREADS + tid_l(), gs = gridDim.x * NTHREADS;
    for (int idx = gt; idx < 4 * 256 * 8 * 16; idx += gs) {
        const int d8 = idx & 15, h = (idx >> 4) & 7, s = (idx >> 7) & 255, b = idx >> 15;
        const float* src = p->in[2] + ((size_t)((b * 2 + j) * 256 + s) * 8 + h) * 128 + d8 * 8;
        const f32x4 v0 = *(const f32x4*)src, v1 = *(const f32x4*)(src + 4);
        const int mm = d8 >> 3, d = (d8 & 7) * 8;
        u16* dst = (u16*)(p->ws + UA_KL) + ((size_t)((b * 8 + h) * 2 + mm) * 1280 + 1024 + s) * 64 + d;
        pg8::u32x4 o; o.x = pk2(v0[0], v0[1]); o.y = pk2(v0[2], v0[3]); o.z = pk2(v1[0], v1[1]); o.w = pk2(v1[2], v1[3]);
        *(pg8::u32x4*)dst = o;
    }
    for (int idx = gt; idx < 4 * 256 * 8 * 16; idx += gs) {
        const int s = idx & 255, d8 = (idx >> 8) & 15, h = (idx >> 12) & 7, b = idx >> 15;
        const float* src = p->in[3] + ((size_t)((b * 2 + j) * 256 + s) * 8 + h) * 128 + d8 * 8;
        const f32x4 v0 = *(const f32x4*)src, v1 = *(const f32x4*)(src + 4);
        u16* dst = (u16*)(p->ws + UA_VTL) + ((size_t)(b * 8 + h) * 128 + d8 * 8) * 1280 + 1024 + s;
        dst[0] = f2bf(v0[0]); dst[1280] = f2bf(v0[1]); dst[2560] = f2bf(v0[2]); dst[3840] = f2bf(v0[3]);
        dst[5120] = f2bf(v1[0]); dst[6400] = f2bf(v1[1]); dst[7680] = f2bf(v1[2]); dst[8960] = f2bf(v1[3]);
    }
}

__device__ __forceinline__ void phase_p0b(KP p) {
    const float* mod = (const float*)(p->ws + WS_MOD);
    u16* A = (u16*)(p->ws + WS_ABUF);
    for (int idx = blockIdx.x * NTHREADS + tid_l(); idx < 8192 * 128; idx += gridDim.x * NTHREADS) {
        const int r = idx >> 7, c = (idx & 127) * 8;
        const float* x = (r < 4096) ? p->in[0] + (size_t)r * 1024 + c : p->in[1] + (size_t)(r - 4096) * 1024 + c;
        const float* md = mod + (size_t)row_n5(r) * 3072;
        const f32x4 x0 = *(const f32x4*)x, x1 = *(const f32x4*)(x + 4);
        const f32x4 sh0 = *(const f32x4*)(md + c), sh1 = *(const f32x4*)(md + c + 4), sc0 = *(const f32x4*)(md + 1024 + c), sc1 = *(const f32x4*)(md + 1024 + c + 4);
        const f32x4 h0 = x0 * (sc0 + 1.0f) + sh0, h1 = x1 * (sc1 + 1.0f) + sh1;
        pg8::u32x4 o; o.x = pk2(h0[0], h0[1]); o.y = pk2(h0[2], h0[3]); o.z = pk2(h1[0], h1[1]); o.w = pk2(h1[2], h1[3]);
        *(pg8::u32x4*)(A + (size_t)r * 1024 + c) = o;
    }
}

__device__ __forceinline__ void phase_ln(KP p, int li, int nxt, bool dry = false) {
    const int tid = tid_l(), w = tid >> 6, lane = tid & 63;
    const float* g = p->in[10] + li * 1024; const float* bb = p->in[11] + li * 1024;
    u16* A = (u16*)(p->ws + (dry ? UR_G : WS_ABUF));
    for (int r = blockIdx.x * 8 + w; r < 8192; r += gridDim.x * 8) {
        float* x = p->out + (size_t)r * 1024;
        float* xo = dry ? (float*)(p->ws + UR_O) + (size_t)r * 1024 : x;
        const float* x2 = (const float*)(p->ws + WS_X2) + (size_t)r * 1024;
        f32x4 v[4];
        float s = 0.f;
#pragma unroll
        for (int q = 0; q < 4; ++q) { v[q] = *(const f32x4*)(x + q * 256 + lane * 4) + *(const f32x4*)(x2 + q * 256 + lane * 4); s += v[q][0] + v[q][1] + v[q][2] + v[q][3]; }
#pragma unroll
        for (int o = 32; o; o >>= 1) s += __shfl_xor(s, o, 64);
        const float mu = s * (1.0f / 1024.0f);
        float ss = 0.f;
#pragma unroll
        for (int q = 0; q < 4; ++q) { v[q] = v[q] - mu; ss += v[q][0] * v[q][0] + v[q][1] * v[q][1] + v[q][2] * v[q][2] + v[q][3] * v[q][3]; }
#pragma unroll
        for (int o = 32; o; o >>= 1) ss += __shfl_xor(ss, o, 64);
        const float rstd = rsqrtf(ss * (1.0f / 1024.0f) + 1e-5f);
        const float* md = (const float*)(p->ws + WS_MOD) + ((size_t)(nxt < 4 ? nxt : 0) * 5 + row_n5(r)) * 3072;
#pragma unroll
        for (int q = 0; q < 4; ++q) {
            const int c = q * 256 + lane * 4;
            const f32x4 xn = v[q] * rstd * *(const f32x4*)(g + c) + *(const f32x4*)(bb + c);
            *(f32x4*)(xo + c) = xn;
            if (nxt < 4) {
                const f32x4 h = xn * (*(const f32x4*)(md + 1024 + c) + 1.0f) + *(const f32x4*)(md + c);
                *(u32x2*)(A + (size_t)r * 1024 + c) = pk4(h);
            }
        }
    }
}

__device__ __forceinline__ void phase_attn(KP p, int j, LAS unsigned char* lds) {
    const int tid = tid_l(), w = tid >> 6, lane = tid & 63, lr = lane & 15, lq = lane >> 4;
    LAS u16* sm = (LAS u16*)lds;
    float la = p->in[13][j * 256 + lane] * p->in[13][j * 256 + 64 + lane], lb = p->in[13][j * 256 + 128 + lane] * p->in[13][j * 256 + 192 + lane];
#pragma unroll
    for (int o = 32; o; o >>= 1) { la += __shfl_xor(la, o, 64); lb += __shfl_xor(lb, o, 64); }
    const float lam_init = p->lam_init[j];
    const float lamv = __expf(la) - __expf(lb) + lam_init;
    const float* subln = p->in[14] + j * 128;
    const u16* Q = (const u16*)(p->ws + UA_Q);
    const u16* Z = (const u16*)(p->ws + UA_Z);
    u16* A = (u16*)(p->ws + WS_ABUF);
    const float SC = 0.125f * LOG2E;
    for (int it = blockIdx.x; it < 512; it += gridDim.x) {
        int b, h, r0, nkeys; const u16* Kb; const u16* Vb;
        if (it < 256) { b = it >> 6; h = (it >> 3) & 7; r0 = 4096 + b * 1024 + (it & 7) * 128; nkeys = 1280;
            Kb = (const u16*)(p->ws + UA_KL) + (size_t)(b * 8 + h) * 2 * 1280 * 64; Vb = (const u16*)(p->ws + UA_VTL) + (size_t)(b * 8 + h) * 128 * 1280; }
        else { const int i2 = it - 256; b = i2 >> 4; h = (i2 >> 1) & 7; r0 = b * 256 + (i2 & 1) * 128; nkeys = 256;
            Kb = (const u16*)(p->ws + UA_KC) + (size_t)(b * 8 + h) * 2 * 256 * 64; Vb = (const u16*)(p->ws + UA_VTC) + (size_t)(b * 8 + h) * 128 * 256; }
        const int row_a = r0 + w * 16 + lr;
        bf16x8 qf[2][2];
#pragma unroll
        for (int m = 0; m < 2; ++m)
#pragma unroll
            for (int ks = 0; ks < 2; ++ks) qf[m][ks] = *(const bf16x8*)(Q + (size_t)row_a * 1024 + h * 128 + m * 64 + ks * 32 + lq * 8);
        f32x4 O[2][8];
        float mrow[2], lsum[2];
#pragma unroll
        for (int m = 0; m < 2; ++m) {
#pragma unroll
            for (int n = 0; n < 8; ++n) O[m][n] = (f32x4){0.f, 0.f, 0.f, 0.f};
            mrow[m] = -1e30f; lsum[m] = 0.f;
        }
        const int ntiles = nkeys >> 6;
        const int krow = tid >> 3, kseg = (tid & 7) * 8, vrow = tid >> 2, vseg = (tid & 3) * 16;
        bf16x8 g0, g1, g2, g3;
        g0 = *(const bf16x8*)(Kb + (size_t)krow * 64 + kseg);
        g1 = *(const bf16x8*)(Kb + (size_t)(nkeys + krow) * 64 + kseg);
        g2 = *(const bf16x8*)(Vb + (size_t)vrow * nkeys + vseg);
        g3 = *(const bf16x8*)(Vb + (size_t)vrow * nkeys + vseg + 8);
        *(LAS bf16x8*)(sm + krow * 72 + kseg) = g0; *(LAS bf16x8*)(sm + 4608 + krow * 72 + kseg) = g1;
        *(LAS bf16x8*)(sm + 9216 + vrow * 72 + vseg) = g2; *(LAS bf16x8*)(sm + 9216 + vrow * 72 + vseg + 8) = g3;
        __syncthreads();
        for (int kt = 0; kt < ntiles; ++kt) {
            const int cur = kt & 1;
            const bool more = kt + 1 < ntiles;
            if (more) {
                const int k0 = (kt + 1) * 64;
                g0 = *(const bf16x8*)(Kb + (size_t)(k0 + krow) * 64 + kseg);
                g1 = *(const bf16x8*)(Kb + (size_t)(nkeys + k0 + krow) * 64 + kseg);
                g2 = *(const bf16x8*)(Vb + (size_t)vrow * nkeys + k0 + vseg);
                g3 = *(const bf16x8*)(Vb + (size_t)vrow * nkeys + k0 + vseg + 8);
            }
            const LAS u16* bK = sm + cur * 18432; const LAS u16* bV = bK + 9216;
            f32x4 s[2][4];
#pragma unroll
            for (int m = 0; m < 2; ++m)
#pragma unroll
                for (int n = 0; n < 4; ++n) s[m][n] = (f32x4){0.f, 0.f, 0.f, 0.f};
#pragma unroll
            for (int m = 0; m < 2; ++m)
#pragma unroll
                for (int ks = 0; ks < 2; ++ks)
#pragma unroll
                    for (int n = 0; n < 4; ++n) {
                        const bf16x8 kf = *(const LAS bf16x8*)(bK + m * 4608 + (n * 16 + lr) * 72 + ks * 32 + lq * 8);
                        s[m][n] = MFMA16(kf, qf[m][ks], s[m][n]);
                    }
            bf16x8 pf[2][2];
#pragma unroll
            for (int m = 0; m < 2; ++m) {
                float mx = -1e30f;
#pragma unroll
                for (int n = 0; n < 4; ++n)
#pragma unroll
                    for (int i = 0; i < 4; ++i) { s[m][n][i] *= SC; mx = fmaxf(mx, s[m][n][i]); }
                mx = fmaxf(mx, __shfl_xor(mx, 16, 64)); mx = fmaxf(mx, __shfl_xor(mx, 32, 64));
                const float mn = fmaxf(mrow[m], mx);
                const float al = ex2(mrow[m] - mn);
                mrow[m] = mn;
                if (__builtin_amdgcn_ballot_w64(al != 1.0f) != 0ull) {
#pragma unroll
                    for (int n = 0; n < 8; ++n) O[m][n] = O[m][n] * al;
                }
                float ls = 0.f;
#pragma unroll
                for (int n = 0; n < 4; ++n)
#pragma unroll
                    for (int i = 0; i < 4; ++i) { s[m][n][i] = ex2(s[m][n][i] - mn); ls += s[m][n][i]; }
                lsum[m] = lsum[m] * al + ls;
#pragma unroll
                for (int k2 = 0; k2 < 2; ++k2) {
                    pg8::u32x4 pk; pk.x = pk2(s[m][2 * k2][0], s[m][2 * k2][1]); pk.y = pk2(s[m][2 * k2][2], s[m][2 * k2][3]);
                    pk.z = pk2(s[m][2 * k2 + 1][0], s[m][2 * k2 + 1][1]); pk.w = pk2(s[m][2 * k2 + 1][2], s[m][2 * k2 + 1][3]);
                    pf[m][k2] = __builtin_bit_cast(bf16x8, pk);
                }
            }
#pragma unroll
            for (int k2 = 0; k2 < 2; ++k2)
#pragma unroll
                for (int n = 0; n < 8; ++n) {
                    const u32x2 va = *(const LAS u32x2*)(bV + (n * 16 + lr) * 72 + k2 * 32 + lq * 4);
                    const u32x2 vb = *(const LAS u32x2*)(bV + (n * 16 + lr) * 72 + k2 * 32 + 16 + lq * 4);
                    pg8::u32x4 vv; vv.x = va.x; vv.y = va.y; vv.z = vb.x; vv.w = vb.y;
                    const bf16x8 vf = __builtin_bit_cast(bf16x8, vv);
                    O[0][n] = MFMA16(vf, pf[0][k2], O[0][n]);
                    O[1][n] = MFMA16(vf, pf[1][k2], O[1][n]);
                }
            if (more) {
                LAS u16* nb = sm + (cur ^ 1) * 18432;
                *(LAS bf16x8*)(nb + krow * 72 + kseg) = g0; *(LAS bf16x8*)(nb + 4608 + krow * 72 + kseg) = g1;
                *(LAS bf16x8*)(nb + 9216 + vrow * 72 + vseg) = g2; *(LAS bf16x8*)(nb + 9216 + vrow * 72 + vseg + 8) = g3;
            }
            __syncthreads();
        }
        float l0 = lsum[0], l1 = lsum[1];
        l0 += __shfl_xor(l0, 16, 64); l0 += __shfl_xor(l0, 32, 64);
        l1 += __shfl_xor(l1, 16, 64); l1 += __shfl_xor(l1, 32, 64);
        const float i0 = 1.0f / l0, i1 = lamv / l1;
        float ss = 0.f;
#pragma unroll
        for (int n = 0; n < 8; ++n) {
            O[0][n] = O[0][n] * i0 - O[1][n] * i1;
            ss += O[0][n][0] * O[0][n][0] + O[0][n][1] * O[0][n][1] + O[0][n][2] * O[0][n][2] + O[0][n][3] * O[0][n][3];
        }
        ss += __shfl_xor(ss, 16, 64); ss += __shfl_xor(ss, 32, 64);
        const float rstd = rsqrtf(ss * (1.0f / 128.0f) + 1e-6f) * (1.0f - lam_init);
#pragma unroll
        for (int n = 0; n < 8; ++n) {
            const int dv = n * 16 + lq * 4;
            const size_t off = (size_t)row_a * 1024 + h * 128 + dv;
            const u32x2 zz = *(const u32x2*)(Z + off);
            const f32x4 sg = *(const f32x4*)(subln + dv);
            f32x4 o;
            o[0] = O[0][n][0] * rstd * sg[0] * bf2f((u16)(zz.x & 0xffffu)); o[1] = O[0][n][1] * rstd * sg[1] * bf2f((u16)(zz.x >> 16));
            o[2] = O[0][n][2] * rstd * sg[2] * bf2f((u16)(zz.y & 0xffffu)); o[3] = O[0][n][3] * rstd * sg[3] * bf2f((u16)(zz.y >> 16));
            *(u32x2*)(A + off) = pk4(o);
        }
    }
}

__device__ __forceinline__ void phase_ret(KP p, LAS unsigned char* lds) {
    const int tid = tid_l(), w = tid >> 6, lane = tid & 63, lr = lane & 15, lq = lane >> 4;
    LAS u16* sm = (LAS u16*)lds;
    const u16* QR = (const u16*)(p->ws + UR_QR); const u16* KR = (const u16*)(p->ws + UR_KR);
    const u16* KTR = (const u16*)(p->ws + UR_KTR); const u16* VTR = (const u16*)(p->ws + UR_VTR);
    const u16* S0T = (const u16*)(p->ws + UR_SB);
    u16* OB = (u16*)(p->ws + UR_O);
    for (int it = blockIdx.x; it < 512; it += gridDim.x) {
        const bool lat = it < 256;
        int b, h, qt, dvh, r0, T;
        if (lat) { b = it >> 6; h = (it >> 4) & 3; qt = (it >> 1) & 7; dvh = it & 1; r0 = 4096 + b * 1024; T = 1024; }
        else { const int i2 = it - 256; b = i2 >> 4; h = (i2 >> 2) & 3; qt = (i2 >> 1) & 1; dvh = i2 & 1; r0 = b * 256; T = 256; }
        const float lgf2 = log1pf(-expf(p->in[17][h])) * LOG2E, lgb2 = log1pf(-expf(p->in[18][h])) * LOG2E;
        const int nkey = T >> 6, nsteps = lat ? nkey + 8 : nkey;
        const int qpos = qt * 128 + w * 16 + lr;
        const size_t qrow = (size_t)(r0 + qpos);
        bf16x8 qf[8];
#pragma unroll
        for (int ks = 0; ks < 8; ++ks) qf[ks] = *(const bf16x8*)(QR + qrow * 1024 + h * 256 + ks * 32 + lq * 8);
        f32x4 O[16];
#pragma unroll
        for (int n = 0; n < 16; ++n) O[n] = (f32x4){0.f, 0.f, 0.f, 0.f};
        const u16* kbase = KR + (size_t)r0 * 1024 + h * 256;
        const u16* vbase = VTR + (size_t)(h * 512 + dvh * 256) * 8192 + r0;
        const u16* sbase = S0T + (size_t)(b * 4 + h) * 131072 + (size_t)(dvh * 256) * 256;
        bf16x8 gk[4], gv[4];
#define RET_ISSUE(st) do { int tvv = tid; asm volatile("" : "+v"(tvv)); \
            if ((st) < nkey) { \
                _Pragma("unroll") for (int k = 0; k < 4; ++k) { const int idx = tvv + k * 512; \
                    gk[k] = *(const bf16x8*)(kbase + (size_t)((st) * 64 + (idx >> 5)) * 1024 + (idx & 31) * 8); \
                    gv[k] = *(const bf16x8*)(vbase + (size_t)(idx >> 3) * 8192 + (st) * 64 + (idx & 7) * 8); } \
            } else { const int s2 = (st) - nkey; const u16* sb = sbase + (size_t)(s2 >> 2) * 16 * 131072 + (s2 & 3) * 64; \
                _Pragma("unroll") for (int k = 0; k < 4; ++k) { const int idx = tvv + k * 512; \
                    gv[k] = *(const bf16x8*)(sb + (size_t)(idx >> 3) * 256 + (idx & 7) * 8); } } } while (0)
#define RET_COMMIT(st, buf) do { LAS u16* bb = sm + (buf) * 35328; int tvv = tid; asm volatile("" : "+v"(tvv)); \
            if ((st) < nkey) { _Pragma("unroll") for (int k = 0; k < 4; ++k) { const int idx = tvv + k * 512; \
                    *(LAS bf16x8*)(bb + (idx >> 5) * 264 + (idx & 31) * 8) = gk[k]; } } \
            _Pragma("unroll") for (int k = 0; k < 4; ++k) { const int idx = tvv + k * 512; \
                    *(LAS bf16x8*)(bb + 16896 + (idx >> 3) * 72 + (idx & 7) * 8) = gv[k]; } } while (0)
        RET_ISSUE(0);
        __syncthreads();
        RET_COMMIT(0, 0);
        __syncthreads();
        for (int st = 0; st < nsteps; ++st) {
            const int cur = st & 1;
            const bool more = st + 1 < nsteps;
            if (more) RET_ISSUE(st + 1);
            const LAS u16* bK = sm + cur * 35328; const LAS u16* bV = bK + 16896;
            float lf = lgf2, lb = lgb2; int lqv = lq, qpv = qpos; asm volatile("" : "+v"(lf), "+v"(lb), "+v"(lqv), "+v"(qpv));
            if (st < nkey) {
                f32x4 s4[4];
#pragma unroll
                for (int n = 0; n < 4; ++n) s4[n] = (f32x4){0.f, 0.f, 0.f, 0.f};
#pragma unroll
                for (int ks = 0; ks < 8; ++ks)
#pragma unroll
                    for (int n = 0; n < 4; ++n) {
                        const bf16x8 kf = *(const LAS bf16x8*)(bK + (n * 16 + lr) * 264 + ks * 32 + lq * 8);
                        s4[n] = MFMA16(kf, qf[ks], s4[n]);
                    }
#pragma unroll
                for (int n = 0; n < 4; ++n)
#pragma unroll
                    for (int i = 0; i < 4; ++i) {
                        const int df = qpv - (st * 64 + n * 16 + lqv * 4 + i);
                        const float e = ex2((df > 0 ? lf : -lb) * (float)df);
                        s4[n][i] *= (df == 0) ? 2.0f : e;
                    }
#pragma unroll
                for (int k2 = 0; k2 < 2; ++k2) {
                    pg8::u32x4 pk; pk.x = pk2(s4[2 * k2][0], s4[2 * k2][1]); pk.y = pk2(s4[2 * k2][2], s4[2 * k2][3]);
                    pk.z = pk2(s4[2 * k2 + 1][0], s4[2 * k2 + 1][1]); pk.w = pk2(s4[2 * k2 + 1][2], s4[2 * k2 + 1][3]);
                    const bf16x8 pf = __builtin_bit_cast(bf16x8, pk);
#pragma unroll
                    for (int n = 0; n < 16; ++n) {
                        const u32x2 va = *(const LAS u32x2*)(bV + (n * 16 + lr) * 72 + k2 * 32 + lq * 4);
                        const u32x2 vb = *(const LAS u32x2*)(bV + (n * 16 + lr) * 72 + k2 * 32 + 16 + lq * 4);
                        pg8::u32x4 vv; vv.x = va.x; vv.y = va.y; vv.z = vb.x; vv.w = vb.y;
                        O[n] = MFMA16(__builtin_bit_cast(bf16x8, vv), pf, O[n]);
                    }
                }
            } else {
                const int s2 = st - nkey, dt = s2 & 3;
                const float qd = (s2 < 4) ? ex2(lf * (float)(qpv + 1)) : ex2(lb * (float)(T - qpv));
#pragma unroll
                for (int k2 = 0; k2 < 2; ++k2) {
                    bf16x8 qsrc = qf[0];
#pragma unroll
                    for (int ks = 0; ks < 8; ++ks) if (ks == dt * 2 + k2) qsrc = qf[ks];
                    const pg8::u32x4 qu = __builtin_bit_cast(pg8::u32x4, qsrc);
                    pg8::u32x4 qo;
                    qo.x = pk2(__uint_as_float(qu.x << 16) * qd, __uint_as_float(qu.x & 0xffff0000u) * qd);
                    qo.y = pk2(__uint_as_float(qu.y << 16) * qd, __uint_as_float(qu.y & 0xffff0000u) * qd);
                    qo.z = pk2(__uint_as_float(qu.z << 16) * qd, __uint_as_float(qu.z & 0xffff0000u) * qd);
                    qo.w = pk2(__uint_as_float(qu.w << 16) * qd, __uint_as_float(qu.w & 0xffff0000u) * qd);
                    const bf16x8 qs = __builtin_bit_cast(bf16x8, qo);
#pragma unroll
                    for (int n = 0; n < 16; ++n) {
                        const bf16x8 sf = *(const LAS bf16x8*)(bV + (n * 16 + lr) * 72 + k2 * 32 + lq * 8);
                        O[n] = MFMA16(sf, qs, O[n]);
                    }
                }
            }
            if (more) RET_COMMIT(st + 1, cur ^ 1);
            __syncthreads();
        }
#pragma unroll
        for (int n = 0; n < 16; ++n)
            *(u32x2*)(OB + qrow * 2048 + h * 512 + dvh * 256 + n * 16 + lq * 4) = pk4(O[n]);
    }
#undef RET_ISSUE
#undef RET_COMMIT
    for (int it = blockIdx.x; it < 512; it += gridDim.x) {
        const int b = it >> 5, h = (it >> 3) & 3, ds = it & 7, r0 = b * 256;
        const float lgf2 = log1pf(-expf(p->in[17][h])) * LOG2E, lgb2 = log1pf(-expf(p->in[18][h])) * LOG2E;
        LAS u16* vF = sm; LAS u16* vB = sm + 16896;
        int tv = tid; asm volatile("" : "+v"(tv));
        __syncthreads();
#pragma unroll 1
        for (int k = 0; k < 4; ++k) {
            const int idx = tv + k * 512, row = idx >> 5, seg = idx & 31;
            const bf16x8 v = *(const bf16x8*)(VTR + (size_t)(h * 512 + ds * 64 + row) * 8192 + r0 + seg * 8);
            const pg8::u32x4 vu = __builtin_bit_cast(pg8::u32x4, v);
            float f[8];
            f[0] = __uint_as_float(vu.x << 16); f[1] = __uint_as_float(vu.x & 0xffff0000u); f[2] = __uint_as_float(vu.y << 16); f[3] = __uint_as_float(vu.y & 0xffff0000u);
            f[4] = __uint_as_float(vu.z << 16); f[5] = __uint_as_float(vu.z & 0xffff0000u); f[6] = __uint_as_float(vu.w << 16); f[7] = __uint_as_float(vu.w & 0xffff0000u);
            pg8::u32x4 of, ob;
            float df[8], db[8];
#pragma unroll
            for (int q = 0; q < 8; ++q) { const int m = seg * 8 + q; df[q] = f[q] * ex2(lgf2 * (float)(255 - m)); db[q] = f[q] * ex2(lgb2 * (float)m); }
            of.x = pk2(df[0], df[1]); of.y = pk2(df[2], df[3]); of.z = pk2(df[4], df[5]); of.w = pk2(df[6], df[7]);
            ob.x = pk2(db[0], db[1]); ob.y = pk2(db[2], db[3]); ob.z = pk2(db[4], db[5]); ob.w = pk2(db[6], db[7]);
            *(LAS pg8::u32x4*)(vF + row * 264 + seg * 8) = of;
            *(LAS pg8::u32x4*)(vB + row * 264 + seg * 8) = ob;
        }
        __syncthreads();
        f32x4 SF[4][2], SBk[4][2];
#pragma unroll
        for (int n = 0; n < 4; ++n)
#pragma unroll
            for (int c = 0; c < 2; ++c) { SF[n][c] = (f32x4){0.f, 0.f, 0.f, 0.f}; SBk[n][c] = (f32x4){0.f, 0.f, 0.f, 0.f}; }
        const u16* ktw = KTR + (size_t)(h * 256 + w * 32 + lr) * 8192 + r0 + lq * 8;
#pragma unroll
        for (int half = 0; half < 2; ++half) {
            bf16x8 kf[4][2];
#pragma unroll
            for (int k4 = 0; k4 < 4; ++k4)
#pragma unroll
                for (int c = 0; c < 2; ++c) kf[k4][c] = *(const bf16x8*)(ktw + (size_t)c * 16 * 8192 + (half * 4 + k4) * 32);
#pragma unroll
            for (int k4 = 0; k4 < 4; ++k4)
#pragma unroll
                for (int n = 0; n < 4; ++n) {
                    const bf16x8 a = *(const LAS bf16x8*)(vF + (n * 16 + lr) * 264 + (half * 4 + k4) * 32 + lq * 8);
                    const bf16x8 bb = *(const LAS bf16x8*)(vB + (n * 16 + lr) * 264 + (half * 4 + k4) * 32 + lq * 8);
#pragma unroll
                    for (int c = 0; c < 2; ++c) { SF[n][c] = MFMA16(a, kf[k4][c], SF[n][c]); SBk[n][c] = MFMA16(bb, kf[k4][c], SBk[n][c]); }
                }
        }
        const size_t st_off = (size_t)(b * 4 + h) * 131072 + ds * 64;
#pragma unroll
        for (int n = 0; n < 4; ++n)
#pragma unroll
            for (int c = 0; c < 2; ++c) {
                const size_t o = st_off + (size_t)(w * 32 + c * 16 + lr) * 512 + n * 16 + lq * 4;
                *(f32x4*)(p->out + OUT_NSF + o) = SF[n][c];
                *(f32x4*)(p->out + OUT_NSB + o) = SBk[n][c];
            }
    }
}

__device__ __forceinline__ void phase_retfin(KP p) {
    const int tid = tid_l(), w = tid >> 6, lane = tid & 63;
    const u16* OB = (const u16*)(p->ws + UR_O); const u16* Gb = (const u16*)(p->ws + UR_G);
    u16* A2 = (u16*)(p->ws + UR_QR);
    for (int rh = blockIdx.x * 8 + w; rh < 8192 * 4; rh += gridDim.x * 8) {
        const size_t off = (size_t)(rh >> 2) * 2048 + (rh & 3) * 512 + lane * 8;
        const bf16x8 o = *(const bf16x8*)(OB + off), g = *(const bf16x8*)(Gb + off);
        float of[8]; float ss = 0.f;
#pragma unroll
        for (int q = 0; q < 8; ++q) { of[q] = bf2f((u16)o[q]); ss += of[q] * of[q]; }
#pragma unroll
        for (int s = 32; s; s >>= 1) ss += __shfl_xor(ss, s, 64);
        const float rstd = rsqrtf(ss * (1.0f / 512.0f) + 1e-6f);
        bf16x8 a;
#pragma unroll
        for (int q = 0; q < 8; ++q) a[q] = (short)f2bf(of[q] * rstd * bf2f((u16)g[q]));
        *(bf16x8*)(A2 + off) = a;
    }
}

__device__ __forceinline__ void phase_convfin(KP p) {
    const u16* T1 = (const u16*)(p->ws + UC_T1); const u16* PC = (const u16*)(p->ws + UC_PC);
    u16* A = (u16*)(p->ws + WS_ABUF);
    const float* cw = p->in[21];
    for (int idx = blockIdx.x * NTHREADS + tid_l(); idx < 8192 * 128; idx += gridDim.x * NTHREADS) {
        const int r = idx >> 7, e = (idx & 127) * 8;
        const int t = r < 4096 ? (r & 255) : (r & 1023), T = r < 4096 ? 256 : 1024;
        const size_t off = (size_t)r * 1024 + e;
        const bf16x8 t1 = *(const bf16x8*)(T1 + off), pc = *(const bf16x8*)(PC + off);
        bf16x8 pp, pn;
#pragma unroll
        for (int q = 0; q < 8; ++q) { pp[q] = 0; pn[q] = 0; }
        if (t > 0) pp = *(const bf16x8*)(PC + off - 1024);
        if (t < T - 1) pn = *(const bf16x8*)(PC + off + 1024);
        bf16x8 a;
#pragma unroll
        for (int q = 0; q < 8; ++q) {
            const float cv = cw[e + q] * bf2f((u16)pp[q]) + cw[1024 + e + q] * bf2f((u16)pc[q]) + cw[2048 + e + q] * bf2f((u16)pn[q]);
            a[q] = (short)f2bf(bf2f((u16)t1[q]) * cv);
        }
        *(bf16x8*)(A + off) = a;
    }
}

#define XBAR(xb) do { _Pragma("nounroll") for (int _r = 0; _r < REP_BAR; ++_r) xcd_barrier(xb); } while (0)
__global__ void __launch_bounds__(512) mega(Prm p_unused) {
    const KP kp = (KP)__builtin_amdgcn_kernarg_segment_ptr();
    extern __shared__ __attribute__((aligned(16))) unsigned char shm[];
    LAS unsigned char* lds = (LAS unsigned char*)shm;
    cg::grid_group grid = cg::this_grid();
    pg8::StaticOrder S;
    volatile LAS unsigned* xst = (volatile LAS unsigned*)(lds + LDS_MAIN);
    if (threadIdx.x == 0) { xst[0] = 0u; xst[1] = 0u; xst[2] = 0u; xst[3] = 0u; }
    __syncthreads();
    XcdBarrier xb = xcd_barrier_post((unsigned*)(kp->ws + WS_BAR), xst);
#pragma nounroll
    for (int rep = 0; rep < REP_P0A; ++rep) phase_p0a(lp(kp), lds);
    if (gridDim.x == 0x7fffffffu) grid.sync();
    XBAR(xb);
#pragma nounroll
    for (int rep = 0; rep < REP_EW; ++rep) { phase_p0b(lp(kp)); cache_convert(lp(kp), 0); }
    XBAR(xb);
    for (int li = 0; li < 4; ++li) {
        const int kind = li % 3, j = li / 3;
        const KP p = lp(kp);
        {
            pg8::Gemm g; g.A = (const u16*)(p->ws + WS_ABUF); g.M = 8192; g.K = 1024; g.KL = 1024;
            if (kind == 0) { g.Bt = (const u16*)(p->ws + (j == 0 ? WS_WT_A0 : WS_WT_A1)); g.N = 4096; }
            else if (kind == 1) { g.Bt = (const u16*)(p->ws + WS_WT_B); g.N = 6144; }
            else { g.Bt = (const u16*)(p->ws + WS_WT_C); g.N = 4096; }
            Epi E; E.kind = kind; E.layer = li; E.j = j; E.p = lp(kp);
            S.init(g.M, g.N, (int)gridDim.x, (int)blockIdx.x);
#pragma nounroll
            for (int rep = 0; rep < REP_G1; ++rep) pg8::gemm_phase<Epi, pg8::StaticOrder, false>(lds, g, S, E, nullptr);
        }
        XBAR(xb);
        if (kind == 0) {
#pragma nounroll
            for (int rep = 0; rep < REP_ATTN; ++rep) phase_attn(lp(kp), j, lds); }
        else if (kind == 1) {
#pragma nounroll
            for (int rep = 0; rep < REP_RET; ++rep) phase_ret(lp(kp), lds);
            XBAR(xb);
#pragma nounroll
            for (int rep = 0; rep < REP_EW; ++rep) phase_retfin(lp(kp)); }
        else {
#pragma nounroll
            for (int rep = 0; rep < REP_EW; ++rep) phase_convfin(lp(kp)); }
        XBAR(xb);
        {
            pg8::Gemm g; g.M = 8192; g.N = 1024;
            if (kind == 0) { g.A = (const u16*)(p->ws + WS_ABUF); g.Bt = (const u16*)(p->ws + (j == 0 ? WS_WT_OA0 : WS_WT_OA1)); g.K = 1024; }
            else if (kind == 1) { g.A = (const u16*)(p->ws + UR_QR); g.Bt = (const u16*)(p->ws + WS_WT_OB); g.K = 2048; }
            else { g.A = (const u16*)(p->ws + WS_ABUF); g.Bt = (const u16*)(p->ws + WS_WT_OC); g.K = 1024; }
            g.KL = g.K >> 1;
            Epi E; E.kind = 3; E.layer = li; E.j = j; E.p = lp(kp);
            S.init(g.M, g.N, (int)gridDim.x, (int)blockIdx.x, 2);
#pragma nounroll
            for (int rep = 0; rep < (li == 0 ? REP_G2L0 : 1); ++rep) pg8::gemm_phase<Epi, pg8::StaticOrder, false>(lds, g, S, E, nullptr);
        }
        XBAR(xb);
#pragma nounroll
        for (int rep = 0; rep < REP_LN; ++rep) phase_ln(lp(kp), li, li + 1, true);
        phase_ln(lp(kp), li, li + 1);
        if (li == 2) cache_convert(lp(kp), 1);
        XBAR(xb);
    }
}

extern "C" void kernel_launch(void* const* d_in, const int* in_sizes, int n_in, void* d_out, int out_size, void* d_ws, size_t ws_size, hipStream_t stream) {
    static int grid_blocks = 0;
    if (!grid_blocks) {
        int dev = 0, cus = 0, per_cu = 0;
        hipGetDevice(&dev);
        hipDeviceGetAttribute(&cus, hipDeviceAttributeMultiprocessorCount, dev);
        hipFuncSetAttribute((const void*)mega, hipFuncAttributeMaxDynamicSharedMemorySize, LDS_BYTES);
        hipOccupancyMaxActiveBlocksPerMultiprocessor(&per_cu, mega, NTHREADS, LDS_BYTES);
        if (per_cu < 1) per_cu = 1;
        if (per_cu > 1) per_cu = 1;
        grid_blocks = cus * per_cu;
        if (ws_size < WS_NEEDED) fprintf(stderr, "workspace too small: %zu < %zu\n", ws_size, (size_t)WS_NEEDED);
    }
    Prm p{};
    for (int i = 0; i < 23; ++i) p.in[i] = (const float*)d_in[i];
    p.out = (float*)d_out;
    p.ws = (char*)d_ws;
    p.lam_init[0] = (float)(0.8 - 0.6 * exp(-0.3 * 0.0));
    p.lam_init[1] = (float)(0.8 - 0.6 * exp(-0.3 * 3.0));
    hipMemsetAsync((char*)d_ws + WS_BAR, 0, 16384, stream);
    void* args[] = {&p};
    hipError_t e = hipLaunchCooperativeKernel((void*)mega, dim3(grid_blocks), dim3(NTHREADS), args, LDS_BYTES, stream);
    if (e != hipSuccess) fprintf(stderr, "cooperative launch failed: %s (grid %d)\n", hipGetErrorString(e), grid_blocks);
}
```

```cpp
#include <hip/hip_runtime.h>
#include <hip/hip_cooperative_groups.h>
#include <cstdio>
#include <cmath>
namespace cg = cooperative_groups;

namespace pg8 {
#define PG8_LAS __attribute__((address_space(3)))
typedef unsigned short bf16_t;
typedef short bf16x8 __attribute__((ext_vector_type(8)));
typedef float f32x4 __attribute__((ext_vector_type(4)));
typedef unsigned u32x4 __attribute__((ext_vector_type(4)));
constexpr int BM = 256, BK = 64, HALF = 128, HTB = HALF * BK * 2  , STAGE_BYTES = 8 * HTB, NXCD = 8, WGM = 8;
__host__ __device__ __forceinline__ int lds_byte(int r, int c) { const int st = (r >> 4) * 2 + (c >> 5), rr = r & 15, cc = c & 31, ob = rr * 64 + cc * 2; return st * 1024 + (ob ^ (((ob >> 9) & 1) << 5)); }
__host__ __device__ __forceinline__ void stage_rc(int b, int& R, int& C) { const int st = b / 1024, sb = b % 1024, swz = sb ^ (((sb >> 9) & 1) << 5); R = (st >> 1) * 16 + swz / 64; C = (st & 1) * 32 + (swz % 64) / 2; }
__host__ __device__ __forceinline__ int perm32(int rho) { const int n = rho >> 4, i = rho & 15; return 8 * (i >> 2) + 4 * n + (i & 3); }

struct Unit { int pm, pn, kh; };
struct Gemm { const bf16_t* A; const bf16_t* Bt; int M, N, K, KL; };

struct StaticOrder {
    int nM, nN, nwg, G, c, nsplit, wv;
    __host__ __device__ void init(int M, int N, int G_, int c_, int ns = 1) { nM = M / BM; nN = N / BM; nwg = nM * nN; G = G_; c = c_; nsplit = ns; }
    __host__ __device__ bool next(int i, Unit& u) const {
        const long L = (long)i * G + c; if (L >= (long)nwg * nsplit) return false;
        int wgid = (int)(L % nwg); u.kh = (int)(L / nwg); { const int q = nwg / NXCD, r = nwg % NXCD, xcd = wgid % NXCD, off = wgid / NXCD; wgid = (xcd < r ? xcd * (q + 1) : r * (q + 1) + (xcd - r) * q) + off; }
        const int nig = WGM * nN, gid = wgid / nig, fm = gid * WGM, gsz = (nM - fm) < WGM ? (nM - fm) : WGM;
        u.pm = fm + ((wgid % nig) % gsz); u.pn = (wgid % nig) / gsz; return true;
    }
    __device__ __forceinline__ void a_ready(const Unit&) const {}
    __device__ __forceinline__ void done(const Unit&) const {}
};
template <class Epi, class Sched, bool STAMP = false>
__device__ __forceinline__ void gemm_phase(PG8_LAS unsigned char* lds, const Gemm g, const Sched& S, const Epi& E, unsigned long long* stamps) {
    unsigned z_ = 0u; int wv_ = S.wv; asm volatile("" : "+v"(z_), "+s"(wv_)); const int tid_ = (wv_ << 6) | (int)__builtin_amdgcn_mbcnt_hi(~0u, __builtin_amdgcn_mbcnt_lo(~0u, z_)); const int tid = tid_, wid = __builtin_amdgcn_readfirstlane(tid >> 6), lane = tid & 63, wr = wid >> 2, wc = wid & 3, fr = lane & 15, fq = lane >> 4;
    const int K = g.K, nt = g.KL / BK;
    int ts_lo = 0, ts_hi = 0, nts = 0; const unsigned long long rt_entry = STAMP ? (unsigned long long)wall_clock64() : 0ull;
#define PG8_STAMP() do { if (STAMP && wid == 0 && nts < 64) { const unsigned long long _c = (unsigned long long)clock64(); \
        ts_lo = (lane == nts) ? (int)(unsigned)_c : ts_lo; ts_hi = (lane == nts) ? (int)(unsigned)(_c >> 32) : ts_hi; ++nts; } } while (0)
    PG8_STAMP();
    unsigned voffA[2], voffB[2];
#pragma unroll
    for (int i = 0; i < 2; ++i) { int R, C; stage_rc(tid * 16 + i * 8192, R, C); const int Rb = Epi::PERM ? ((R & ~31) + perm32(R & 31)) : R;
        voffA[i] = (unsigned)(R * K + C) * 2u; voffB[i] = (unsigned)(Rb * K + C) * 2u; }
    const size_t kstep = (size_t)(BK * 2);
    const size_t hstep = (size_t)HALF * K * 2;
    const size_t tstep = 2 * hstep;
    const unsigned ldsw = (unsigned)wid * 1024u;
    const int aoff = lds_byte(wr * 64 + fr, fq * 8), boff = lds_byte(wc * 32 + fr, fq * 8);
#define PG8_SA(b, h) (((b) * 2 + (h)) * HTB)
#define PG8_SB(b, h) ((4 + (b) * 2 + (h)) * HTB)
#define PG8_STAGE(bufoff, gbase, voff) do { _Pragma("unroll") for (int _i = 0; _i < 2; ++_i) \
        __builtin_amdgcn_global_load_lds((const unsigned*)((const char*)(gbase) + (voff)[_i]), (PG8_LAS unsigned*)(lds + (bufoff) + ldsw + _i * 8192), 16, 0, 0); } while (0)
#define PG8_LDA(dst, b, h) do { _Pragma("unroll") for (int m = 0; m < 4; ++m) _Pragma("unroll") for (int k = 0; k < 2; ++k) dst[m][k] = *(const PG8_LAS bf16x8*)(lds + PG8_SA(b, h) + aoff + m * 2048 + k * 1024); } while (0)
#define PG8_LDB(dst, b, h) do { _Pragma("unroll") for (int n = 0; n < 2; ++n) _Pragma("unroll") for (int k = 0; k < 2; ++k) dst[n][k] = *(const PG8_LAS bf16x8*)(lds + PG8_SB(b, h) + boff + n * 2048 + k * 1024); } while (0)
#define PG8_MMA(ai, bj, At, Bt) do { __builtin_amdgcn_s_setprio(1); _Pragma("unroll") for (int m = 0; m < 4; ++m) _Pragma("unroll") for (int n = 0; n < 2; ++n) _Pragma("unroll") for (int k = 0; k < 2; ++k) \
        acc[ai][bj][m][n] = __builtin_amdgcn_mfma_f32_16x16x32_bf16(Bt[n][k], At[m][k], acc[ai][bj][m][n], 0, 0, 0); __builtin_amdgcn_s_setprio(0); } while (0)
#define PG8_WAIT_V(n) asm volatile("s_waitcnt vmcnt(" #n ")" ::: "memory")
#define PG8_WAIT_L(n) asm volatile("s_waitcnt lgkmcnt(" #n ")" ::: "memory")
#define PG8_BAR __builtin_amdgcn_s_barrier()
#define PG8_SCHED __builtin_amdgcn_sched_barrier(0)
    Unit cur, nxt; int ui = 0;
    if (!S.next(0, cur)) return;
    f32x4 acc[2][2][4][2];
#pragma unroll
    for (int a = 0; a < 2; ++a)
#pragma unroll
        for (int b = 0; b < 2; ++b)
#pragma unroll
            for (int m = 0; m < 4; ++m)
#pragma unroll
                for (int n = 0; n < 2; ++n) acc[a][b][m][n] = (f32x4){0.f, 0.f, 0.f, 0.f};
    bf16x8 At[4][2], B0[2][2], B1[2][2];
    const char* cA = (const char*)g.A + (size_t)cur.pm * tstep + (size_t)cur.kh * g.KL * 2; const char* cB = (const char*)g.Bt + (size_t)cur.pn * tstep + (size_t)cur.kh * g.KL * 2;
    S.a_ready(cur);
    PG8_STAGE(PG8_SB(0, 0), cB, voffB); PG8_STAGE(PG8_SA(0, 0), cA, voffA); PG8_STAGE(PG8_SB(0, 1), cB + hstep, voffB); PG8_STAGE(PG8_SA(0, 1), cA + hstep, voffA);
    if (wr == 1) PG8_BAR;
    PG8_WAIT_V(4); PG8_BAR;
    PG8_STAGE(PG8_SB(1, 0), cB + kstep, voffB); PG8_STAGE(PG8_SA(1, 0), cA + kstep, voffA); PG8_STAGE(PG8_SB(1, 1), cB + hstep + kstep, voffB);
    PG8_WAIT_V(6); PG8_BAR;
    PG8_STAMP();
    for (;;) {
        const bool has_next = S.next(ui + 1, nxt);
        const char* nA = has_next ? (const char*)g.A + (size_t)nxt.pm * tstep + (size_t)nxt.kh * g.KL * 2 : cA; const char* nB = has_next ? (const char*)g.Bt + (size_t)nxt.pn * tstep + (size_t)nxt.kh * g.KL * 2 : cB;
#ifdef KREP
        for (int t = 0; t < 2 * nt; t += 2) {
            const bool last = (t == 2 * nt - 2);
            const char* a1 = cA + (size_t)((t + 1) % nt) * kstep;
            const char* a2 = last ? nA : cA + (size_t)((t + 2) % nt) * kstep; const char* b2 = last ? nB : cB + (size_t)((t + 2) % nt) * kstep;
#else
        for (int t = 0; t < nt; t += 2) {
            const bool last = (t == nt - 2);
            const char* a1 = cA + (size_t)(t + 1) * kstep;
            const char* a2 = last ? nA : cA + (size_t)(t + 2) * kstep; const char* b2 = last ? nB : cB + (size_t)(t + 2) * kstep;
#endif
            const char* a3 = a2 + kstep; const char* b3 = b2 + kstep;
            if (last && has_next) S.a_ready(nxt);
            PG8_LDB(B0, 0, 0); PG8_SCHED; PG8_LDA(At, 0, 0); PG8_STAGE(PG8_SA(1, 1), a1 + hstep, voffA);
            PG8_WAIT_L(8); PG8_BAR; PG8_WAIT_L(0); PG8_MMA(0, 0, At, B0); PG8_BAR; PG8_SCHED;
            PG8_LDB(B1, 0, 1); PG8_STAGE(PG8_SB(0, 0), b2, voffB);
            PG8_BAR; PG8_WAIT_L(0); PG8_MMA(0, 1, At, B1); PG8_BAR;
            PG8_LDA(At, 0, 1); PG8_STAGE(PG8_SA(0, 0), a2, voffA);
            PG8_BAR; PG8_WAIT_L(0); PG8_MMA(1, 0, At, B0); PG8_BAR; PG8_SCHED;
            PG8_STAGE(PG8_SB(0, 1), b2 + hstep, voffB);
            PG8_WAIT_V(6); PG8_BAR; PG8_MMA(1, 1, At, B1); PG8_BAR;
            PG8_LDB(B0, 1, 0); PG8_SCHED; PG8_LDA(At, 1, 0); PG8_STAGE(PG8_SA(0, 1), a2 + hstep, voffA);
            PG8_WAIT_L(8); PG8_BAR; PG8_WAIT_L(0); PG8_MMA(0, 0, At, B0); PG8_BAR; PG8_SCHED;
            PG8_LDB(B1, 1, 1); PG8_STAGE(PG8_SB(1, 0), b3, voffB);
            PG8_BAR; PG8_WAIT_L(0); PG8_MMA(0, 1, At, B1); PG8_BAR;
            PG8_LDA(At, 1, 1); PG8_STAGE(PG8_SA(1, 0), a3, voffA);
            PG8_BAR; PG8_WAIT_L(0); PG8_MMA(1, 0, At, B0); PG8_BAR; PG8_SCHED;
            PG8_STAGE(PG8_SB(1, 1), b3 + hstep, voffB);
            PG8_WAIT_V(6); PG8_BAR; PG8_MMA(1, 1, At, B1); PG8_BAR;
        }
        PG8_STAMP();
        if constexpr (!Epi::AFTER_DRAIN) {
#ifdef KREP
            _Pragma("unroll") for (int a = 0; a < 2; ++a) _Pragma("unroll") for (int b = 0; b < 2; ++b) _Pragma("unroll") for (int m = 0; m < 4; ++m) _Pragma("unroll") for (int n = 0; n < 2; ++n) acc[a][b][m][n] = acc[a][b][m][n] * 0.5f;
#endif
            E(acc, cur, wr, wc, fr, fq);
            S.done(cur); }
        PG8_STAMP();
        if (!has_next) break;
#pragma unroll
        for (int a = 0; a < 2; ++a)
#pragma unroll
            for (int b = 0; b < 2; ++b)
#pragma unroll
                for (int m = 0; m < 4; ++m)
#pragma unroll
                    for (int n = 0; n < 2; ++n) acc[a][b][m][n] = (f32x4){0.f, 0.f, 0.f, 0.f};
        cur = nxt; cA = nA; cB = nB; ++ui;
    }
    PG8_WAIT_V(0);
    if (wr == 0) PG8_BAR;
    PG8_BAR;
    if constexpr (Epi::AFTER_DRAIN) { E.fused(acc, cur, wr, wc, fr, fq, lds, wid, lane); S.done(cur); }
    PG8_STAMP();
    if (STAMP && wid == 0) { stamps[lane] = lane < nts ? (((unsigned long long)(unsigned)ts_hi << 32) | (unsigned)ts_lo) : 0ull;
        if (lane == 62) stamps[62] = rt_entry; if (lane == 63) stamps[63] = (unsigned long long)wall_clock64(); }
#undef PG8_STAMP
#undef PG8_SA
#undef PG8_SB
#undef PG8_STAGE
#undef PG8_LDA
#undef PG8_LDB
#undef PG8_MMA
#undef PG8_WAIT_V
#undef PG8_WAIT_L
#undef PG8_BAR
#undef PG8_SCHED
}
}

using pg8::bf16x8; using pg8::f32x4;
typedef unsigned short u16;
typedef unsigned u32x2 __attribute__((ext_vector_type(2)));
#define LAS __attribute__((address_space(3)))

#ifndef REP_ATTN
#define REP_ATTN 1
#endif
#ifndef REP_RET
#define REP_RET 1
#endif
#ifndef REP_G1
#define REP_G1 1
#endif
#ifndef REP_P0A
#define REP_P0A 1
#endif
#ifndef REP_G2L0
#define REP_G2L0 1
#endif
#ifndef REP_LN
#define REP_LN 0
#endif
#ifndef REP_BAR
#define REP_BAR 1
#endif
#ifndef REP_EW
#define REP_EW 1
#endif
constexpr int NTHREADS = 512;
constexpr int LDS_MAIN = 141312;
constexpr int LDS_BYTES = LDS_MAIN + 16;
constexpr float LOG2E = 1.4426950408889634f;
constexpr float ALPHA_F = 1.681792830507429f;

constexpr size_t OUT_NCK = 8388608, OUT_NCV = 16777216, OUT_NSF = 25165824, OUT_NSB = 33554432;
constexpr size_t WS_WT_A1 = 0, WS_WT_OA1 = 8388608, WS_WT_B = 10485760, WS_WT_OB = 23068672, WS_WT_C = 27262976, WS_WT_OC = 35651584,
                 WS_MOD = 37748736, WS_ROPE = 38010880, WS_ABUF = 38273024, WS_WT_A0 = 55050240, WS_WT_OA0 = 63438848, WS_UATT = 65536000;
constexpr size_t UA_Q = WS_UATT, UA_Z = WS_UATT + 16777216, UA_KC = WS_UATT + 33554432, UA_KL = WS_UATT + 41943040, UA_VTC = WS_UATT + 52428800, UA_VTL = WS_UATT + 60817408;
constexpr size_t UR_QR = WS_WT_A0, UR_KR = UR_QR + 16777216, UR_KTR = UR_QR + 33554432, UR_VTR = UR_QR + 50331648, UR_G = UR_QR + 83886080, UR_O = UR_QR + 117440512, UR_SB = UR_QR + 150994944;
constexpr size_t UC_T1 = WS_UATT, UC_PC = WS_UATT + 16777216;
constexpr size_t WS_X2 = UR_SB + 8388608;
constexpr size_t WS_BAR = UR_SB + 50331648;
constexpr size_t WS_NEEDED = WS_BAR + 16384;

struct Prm {
    const float* in[23];
    float* out;
    char* ws;
    float lam_init[2];
};

typedef const __attribute__((address_space(4))) Prm* KP;
__device__ __forceinline__ KP lp(KP k) { asm volatile("" : "+s"(k)); return k; }
__device__ __forceinline__ u16 f2bf(float f) { unsigned u = __float_as_uint(f); u += 0x7fffu + ((u >> 16) & 1u); return (u16)(u >> 16); }
__device__ __forceinline__ float bf2f(u16 h) { return __uint_as_float(((unsigned)h) << 16); }
__device__ __forceinline__ unsigned pk2(float lo, float hi) { unsigned r; asm("v_cvt_pk_bf16_f32 %0, %1, %2" : "=v"(r) : "v"(lo), "v"(hi)); return r; }
__device__ __forceinline__ u32x2 pk4(f32x4 v) { u32x2 r; r.x = pk2(v[0], v[1]); r.y = pk2(v[2], v[3]); return r; }
__device__ __forceinline__ float silu_f(float x) { return x * __builtin_amdgcn_rcpf(1.0f + __builtin_amdgcn_exp2f(-x * 1.4426950408889634f)); }
__device__ __forceinline__ float ex2(float x) { return __builtin_amdgcn_exp2f(x); }
__device__ __forceinline__ int tid_l(int wv) { unsigned z = 0u; asm volatile("" : "+v"(z), "+s"(wv)); return (wv << 6) | (int)__builtin_amdgcn_mbcnt_hi(~0u, __builtin_amdgcn_mbcnt_lo(~0u, z)); }
__device__ __forceinline__ float shx(float v, int mask, int lane) { return __builtin_bit_cast(float, __builtin_amdgcn_ds_bpermute((lane ^ mask) << 2, __builtin_bit_cast(int, v))); }
__device__ __forceinline__ int row_n5(int r) { return r < 4096 ? 0 : 1 + ((r - 4096) >> 10); }
#define MFMA16(a, b, c) __builtin_amdgcn_mfma_f32_16x16x32_bf16((a), (b), (c), 0, 0, 0)


#define XB_TMO      128
#define XB_XCNT(j)  (256  + 64 * (j))
#define XB_XSUB(j)  (1280 + 64 * (j))
#define XB_XGEN(j)  (2304 + 64 * (j))
#define XB_TOP      3328
#define XB_TOPGEN   3392
#define XCD_BAR_WORDS 3456
#define XB_SPIN_CAP (1u << 18)
__device__ __forceinline__ unsigned xb_ld(unsigned* p)              { return __hip_atomic_load(p, __ATOMIC_RELAXED, __HIP_MEMORY_SCOPE_AGENT); }
__device__ __forceinline__ unsigned xb_add(unsigned* p, unsigned v) { return __hip_atomic_fetch_add(p, v, __ATOMIC_RELAXED, __HIP_MEMORY_SCOPE_AGENT); }
__device__ __forceinline__ unsigned xb_xcc_id() { return (unsigned)__builtin_amdgcn_s_getreg((3 << 11) | 20) & 0xFu; }
#define XB_SPIN(cond, bar) do { unsigned _sp = 0; while (cond) { __builtin_amdgcn_s_sleep(1); \
    if ((++_sp & 255u) == 0u) { if (xb_ld(&(bar)[XB_TMO])) break; if (_sp > XB_SPIN_CAP) { atomicAdd(&(bar)[XB_TMO], 1u); break; } } } } while (0)
struct XcdBarrier { unsigned* bar; unsigned x; volatile LAS unsigned* st; int wv; };
__device__ __forceinline__ bool xb_first(int wv) { unsigned z = 0u; asm volatile("" : "+v"(z)); return wv == 0 && __builtin_amdgcn_mbcnt_hi(~0u, __builtin_amdgcn_mbcnt_lo(~0u, z)) == 0u; }
__device__ __forceinline__ XcdBarrier xcd_barrier_post(unsigned* bar, volatile LAS unsigned* st, int wv) {
    XcdBarrier b; b.bar = bar; b.x = xb_xcc_id(); b.st = st; b.wv = wv;
    if (xb_first(wv)) (void)xb_add(&bar[XB_XCNT(b.x)], 1u);
    return b;
}
__device__ __forceinline__ void xcd_barrier_complete(unsigned* bar, unsigned x, unsigned& nloc, unsigned& nx) {
    const unsigned G = gridDim.x * gridDim.y * gridDim.z;
    unsigned sum, cnt, mine, sp = 0u;
    for (;;) {
        sum = 0u; cnt = 0u; mine = 0u;
#pragma unroll
        for (unsigned j = 0; j < 16; ++j) { const unsigned c = xb_ld(&bar[XB_XCNT(j)]); sum += c; cnt += (c > 0u) ? 1u : 0u; mine = (j == x) ? c : mine; }
        if (sum == G) break;
        __builtin_amdgcn_s_sleep(1);
        if ((++sp & 255u) == 0u) { if (xb_ld(&bar[XB_TMO])) break; if (sp > XB_SPIN_CAP) { atomicAdd(&bar[XB_TMO], 1u); break; } }
    }
    nloc = mine > 0u ? mine : 1u; nx = cnt > 0u ? cnt : 1u;
}
__device__ __forceinline__ void xcd_barrier(const XcdBarrier& b) {
    asm volatile("s_waitcnt vmcnt(0)" ::: "memory");
    __syncthreads();
    if (xb_first(b.wv)) {
        unsigned* bar = b.bar;
        __builtin_amdgcn_s_waitcnt(0);
        unsigned nloc = b.st[0], nx = b.st[1];
        if (nloc == 0u) { xcd_barrier_complete(bar, b.x, nloc, nx); b.st[0] = nloc; b.st[1] = nx; }
        const unsigned old = xb_add(&bar[XB_XSUB(b.x)], 1u);
        const unsigned gen = old / nloc;
        if (old + 1u == (gen + 1u) * nloc) {
            __builtin_amdgcn_fence(__ATOMIC_RELEASE, "agent");
            asm volatile("s_waitcnt vmcnt(0)" ::: "memory");
            const unsigned og = xb_add(&bar[XB_TOP], 1u);
            const unsigned tg = og / nx;
            if (og + 1u == (tg + 1u) * nx) xb_add(&bar[XB_TOPGEN], 1u);
            else XB_SPIN(xb_ld(&bar[XB_TOPGEN]) == tg, bar);
            __builtin_amdgcn_fence(__ATOMIC_ACQUIRE, "agent");
            xb_add(&bar[XB_XGEN(b.x)], 1u);
            asm volatile("s_waitcnt vmcnt(0)" ::: "memory");
        } else {
            XB_SPIN(xb_ld(&bar[XB_XGEN(b.x)]) == gen, bar);
            __builtin_amdgcn_fence(__ATOMIC_ACQUIRE, "agent");
            asm volatile("s_waitcnt vmcnt(0)" ::: "memory");
        }
    }
    __syncthreads();
}

struct Epi {
    static constexpr bool PERM = false, AFTER_DRAIN = false;
    int kind; int layer; int j;
    KP p;
    __device__ __forceinline__ void operator()(const f32x4 (&acc)[2][2][4][2], const pg8::Unit& u, int wr, int wc, int fr, int fq) const {
        char* ws = p->ws;
        const int pm = u.pm, pn = u.pn;
        if (kind == 0) {
            const bool lat = pm >= 16;
            const int b = lat ? ((pm - 16) >> 2) : pm;
            const int t0 = lat ? (((pm - 16) & 3) << 8) : 0;
            if (pn < 8) {
                const bool isq = pn < 4;
                const int G = ((pn & 3) << 2) + wc, h = G >> 1, mm = G & 1;
                const float* rope = (const float*)(ws + WS_ROPE);
#pragma unroll
                for (int ai = 0; ai < 2; ++ai)
#pragma unroll
                    for (int m = 0; m < 4; ++m) {
                        const int rl = ai * 128 + wr * 64 + m * 16 + fr;
                        const int r = pm * 256 + rl, t = t0 + rl;
#pragma unroll
                        for (int n = 0; n < 2; ++n) {
                            const int dd = 16 * n + 4 * fq;
                            f32x4 x1 = acc[ai][0][m][n], x2 = acc[ai][1][m][n], o1, o2;
                            if (lat) {
                                const f32x4 cs0 = *(const f32x4*)(rope + ((size_t)t * 32 + dd) * 2), cs1 = *(const f32x4*)(rope + ((size_t)t * 32 + dd) * 2 + 4);
                                const float c0 = cs0[0], s0 = cs0[1], c1 = cs0[2], s1 = cs0[3], c2 = cs1[0], s2 = cs1[1], c3 = cs1[2], s3 = cs1[3];
                                o1[0] = x1[0] * c0 - x2[0] * s0; o2[0] = x1[0] * s0 + x2[0] * c0;
                                o1[1] = x1[1] * c1 - x2[1] * s1; o2[1] = x1[1] * s1 + x2[1] * c1;
                                o1[2] = x1[2] * c2 - x2[2] * s2; o2[2] = x1[2] * s2 + x2[2] * c2;
                                o1[3] = x1[3] * c3 - x2[3] * s3; o2[3] = x1[3] * s3 + x2[3] * c3;
                            } else { o1 = x1; o2 = x2; }
                            if (isq) {
                                u16* q = (u16*)(ws + UA_Q) + (size_t)r * 1024 + G * 64 + dd;
                                *(u32x2*)q = pk4(o1); *(u32x2*)(q + 32) = pk4(o2);
                            } else if (lat) {
                                u16* k = (u16*)(ws + UA_KL) + ((size_t)((b * 8 + h) * 2 + mm) * 1280 + t) * 64 + dd;
                                *(u32x2*)k = pk4(o1); *(u32x2*)(k + 32) = pk4(o2);
                            } else {
                                u16* k = (u16*)(ws + UA_KC) + ((size_t)((b * 8 + h) * 2 + mm) * 256 + t) * 64 + dd;
                                *(u32x2*)k = pk4(o1); *(u32x2*)(k + 32) = pk4(o2);
                                float* o = p->out + OUT_NCK + ((size_t)(b * 2 + j) * 256 + t) * 1024 + G * 64 + dd;
                                *(f32x4*)o = o1; *(f32x4*)(o + 32) = o2;
                            }
                        }
                    }
            } else if (pn < 12) {
#pragma unroll
                for (int ai = 0; ai < 2; ++ai)
#pragma unroll
                    for (int m = 0; m < 4; ++m) {
                        const int rl = ai * 128 + wr * 64 + m * 16 + fr;
                        const int t = t0 + rl;
#pragma unroll
                        for (int bj = 0; bj < 2; ++bj)
#pragma unroll
                            for (int n = 0; n < 2; ++n) {
                                const int c = (pn - 8) * 256 + bj * 128 + wc * 32 + n * 16 + 4 * fq;
                                const int h = c >> 7, dv = c & 127;
                                const f32x4 v = acc[ai][bj][m][n];
                                if (lat) {
                                    u16* vt = (u16*)(ws + UA_VTL) + ((size_t)(b * 8 + h) * 128 + dv) * 1280 + t;
                                    vt[0] = f2bf(v[0]); vt[1280] = f2bf(v[1]); vt[2560] = f2bf(v[2]); vt[3840] = f2bf(v[3]);
                                } else {
                                    u16* vt = (u16*)(ws + UA_VTC) + ((size_t)(b * 8 + h) * 128 + dv) * 256 + t;
                                    vt[0] = f2bf(v[0]); vt[256] = f2bf(v[1]); vt[512] = f2bf(v[2]); vt[768] = f2bf(v[3]);
                                    *(f32x4*)(p->out + OUT_NCV + ((size_t)(b * 2 + j) * 256 + t) * 1024 + c) = v;
                                }
                            }
                    }
            } else {
#pragma unroll
                for (int ai = 0; ai < 2; ++ai)
#pragma unroll
                    for (int m = 0; m < 4; ++m) {
                        const int r = pm * 256 + ai * 128 + wr * 64 + m * 16 + fr;
#pragma unroll
                        for (int bj = 0; bj < 2; ++bj)
#pragma unroll
                            for (int n = 0; n < 2; ++n) {
                                const int c = (pn - 12) * 256 + bj * 128 + wc * 32 + n * 16 + 4 * fq;
                                f32x4 v = acc[ai][bj][m][n];
                                v[0] = silu_f(v[0]); v[1] = silu_f(v[1]); v[2] = silu_f(v[2]); v[3] = silu_f(v[3]);
                                *(u32x2*)((u16*)(ws + UA_Z) + (size_t)r * 1024 + c) = pk4(v);
                            }
                    }
            }
        } else if (kind == 1) {
#pragma unroll
            for (int ai = 0; ai < 2; ++ai)
#pragma unroll
                for (int m = 0; m < 4; ++m) {
                    const int r = pm * 256 + ai * 128 + wr * 64 + m * 16 + fr;
#pragma unroll
                    for (int bj = 0; bj < 2; ++bj)
#pragma unroll
                        for (int n = 0; n < 2; ++n) {
                            const int cb = bj * 128 + wc * 32 + n * 16 + 4 * fq;
                            f32x4 v = acc[ai][bj][m][n];
                            if (pn < 4) {
                                *(u32x2*)((u16*)(ws + UR_QR) + (size_t)r * 1024 + pn * 256 + cb) = pk4(v);
                            } else if (pn < 8) {
                                const int c = (pn - 4) * 256 + cb;
                                v = v * 0.0625f;
                                *(u32x2*)((u16*)(ws + UR_KR) + (size_t)r * 1024 + c) = pk4(v);
                                u16* kt = (u16*)(ws + UR_KTR) + (size_t)c * 8192 + r;
                                kt[0] = f2bf(v[0]); kt[8192] = f2bf(v[1]); kt[16384] = f2bf(v[2]); kt[24576] = f2bf(v[3]);
                            } else if (pn < 16) {
                                const int c = (pn - 8) * 256 + cb;
                                u16* vt = (u16*)(ws + UR_VTR) + (size_t)c * 8192 + r;
                                vt[0] = f2bf(v[0]); vt[8192] = f2bf(v[1]); vt[16384] = f2bf(v[2]); vt[24576] = f2bf(v[3]);
                            } else {
                                const int c = (pn - 16) * 256 + cb;
                                v[0] = silu_f(v[0]); v[1] = silu_f(v[1]); v[2] = silu_f(v[2]); v[3] = silu_f(v[3]);
                                *(u32x2*)((u16*)(ws + UR_G) + (size_t)r * 2048 + c) = pk4(v);
                            }
                        }
                }
        } else if (kind == 2) {
#pragma unroll
            for (int ai = 0; ai < 2; ++ai)
#pragma unroll
                for (int m = 0; m < 4; ++m) {
                    const int r = pm * 256 + ai * 128 + wr * 64 + m * 16 + fr;
                    const int e = pn * 64 + wc * 16 + 4 * fq;
                    const f32x4 bg = acc[ai][0][m][0], cgv = acc[ai][0][m][1], uu = acc[ai][1][m][0], z = acc[ai][1][m][1];
                    f32x4 t1, pc;
#pragma unroll
                    for (int q = 0; q < 4; ++q) { t1[q] = bg[q] * silu_f(z[q]); pc[q] = cgv[q] * uu[q]; }
                    *(u32x2*)((u16*)(ws + UC_T1) + (size_t)r * 1024 + e) = pk4(t1);
                    *(u32x2*)((u16*)(ws + UC_PC) + (size_t)r * 1024 + e) = pk4(pc);
                }
        } else {
            const float* xin = (layer == 0) ? (pm < 16 ? p->in[0] : p->in[1] - (size_t)4096 * 1024) : p->out;
            const float* gate = (const float*)(ws + WS_MOD) + ((size_t)layer * 5 + (pm < 16 ? 0 : 1 + ((pm - 16) >> 2))) * 3072 + 2048;
#pragma unroll
            for (int ai = 0; ai < 2; ++ai)
#pragma unroll
                for (int m = 0; m < 4; ++m) {
                    const int r = pm * 256 + ai * 128 + wr * 64 + m * 16 + fr;
#pragma unroll
                    for (int bj = 0; bj < 2; ++bj)
#pragma unroll
                        for (int n = 0; n < 2; ++n) {
                            const int c = pn * 256 + bj * 128 + wc * 32 + n * 16 + 4 * fq;
                            const f32x4 gv = *(const f32x4*)(gate + c);
                            if (u.kh == 0) {
                                const f32x4 xv = *(const f32x4*)(xin + (size_t)r * 1024 + c);
                                *(f32x4*)(p->out + (size_t)r * 1024 + c) = xv * ALPHA_F + gv * acc[ai][bj][m][n];
                            } else {
                                *(f32x4*)((float*)(ws + WS_X2) + (size_t)r * 1024 + c) = gv * acc[ai][bj][m][n];
                            }
                        }
                }
        }
    }
};

__device__ __forceinline__ int perm_col(int kind, int n) {
    if (kind == 1) {
        if (n >= 2048) return n;
        const int blk = n >> 8, w = n & 255, Gl = w >> 6, half = (w >> 5) & 1, dd = w & 31;
        return (blk << 8) + half * 128 + Gl * 32 + dd;
    } else if (kind == 2) {
        const int part = n >> 10, e = n & 1023, blk = e >> 6, el = e & 63, wc = el >> 4, f = el & 15;
        return blk * 256 + (part >> 1) * 128 + wc * 32 + (part & 1) * 16 + f;
    }
    return n;
}

__device__ __forceinline__ void phase_p0a(int wv, KP p, LAS unsigned char* lds) {
    const int tid = tid_l(wv);
    LAS u16* sT = (LAS u16*)lds;
    LAS float* scond = (LAS float*)(lds + 36864);
    LAS float* red = (LAS float*)(lds + 36864 + 20480);
    for (int i = tid; i < 5120; i += NTHREADS) {
        const int n = i >> 10, k = i & 1023;
        const float v = (n == 0) ? p->in[7][k] : p->in[6][(n - 1) * 1024 + k];
        scond[i] = silu_f(v);
    }
    __syncthreads();
    for (int u = blockIdx.x; u < 192; u += gridDim.x) {
        const int i = u / 48, c0 = (u % 48) * 64;
        const int cg4 = (tid & 15) * 4, ks = tid >> 4;
        const float* w = p->in[8] + (size_t)i * 1024 * 3072 + (size_t)(ks * 32) * 3072 + c0 + cg4;
        f32x4 a0 = {0.f, 0.f, 0.f, 0.f}, a1 = a0, a2 = a0, a3 = a0, a4 = a0;
#pragma unroll 8
        for (int k = 0; k < 32; ++k) {
            const f32x4 wv = *(const f32x4*)(w + (size_t)k * 3072);
            const int kk = ks * 32 + k;
            a0 += wv * scond[kk]; a1 += wv * scond[1024 + kk]; a2 += wv * scond[2048 + kk]; a3 += wv * scond[3072 + kk]; a4 += wv * scond[4096 + kk];
        }
        *(LAS f32x4*)(red + (ks * 5 + 0) * 64 + cg4) = a0; *(LAS f32x4*)(red + (ks * 5 + 1) * 64 + cg4) = a1; *(LAS f32x4*)(red + (ks * 5 + 2) * 64 + cg4) = a2;
        *(LAS f32x4*)(red + (ks * 5 + 3) * 64 + cg4) = a3; *(LAS f32x4*)(red + (ks * 5 + 4) * 64 + cg4) = a4;
        __syncthreads();
        if (tid < 320) {
            const int n = tid >> 6, cc = tid & 63;
            float sacc = p->in[9][i * 3072 + c0 + cc];
#pragma unroll
            for (int q = 0; q < 32; ++q) sacc += red[(q * 5 + n) * 64 + cc];
            ((float*)(p->ws + WS_MOD))[((size_t)i * 5 + n) * 3072 + c0 + cc] = sacc;
        }
        __syncthreads();
    }
    for (int mi = 0; mi < 8; ++mi) {
        const float* W; size_t off; int K, N, kind;
        switch (mi) {
            case 0: W = p->in[12]; off = WS_WT_A0; K = 1024; N = 4096; kind = 1; break;
            case 1: W = p->in[12] + (size_t)1024 * 4096; off = WS_WT_A1; K = 1024; N = 4096; kind = 1; break;
            case 2: W = p->in[15]; off = WS_WT_OA0; K = 1024; N = 1024; kind = 0; break;
            case 3: W = p->in[15] + (size_t)1024 * 1024; off = WS_WT_OA1; K = 1024; N = 1024; kind = 0; break;
            case 4: W = p->in[16]; off = WS_WT_B; K = 1024; N = 6144; kind = 0; break;
            case 5: W = p->in[19]; off = WS_WT_OB; K = 2048; N = 1024; kind = 0; break;
            case 6: W = p->in[20]; off = WS_WT_C; K = 1024; N = 4096; kind = 2; break;
            default: W = p->in[22]; off = WS_WT_OC; K = 1024; N = 1024; kind = 0; break;
        }
        u16* WT = (u16*)(p->ws + off);
        const int ntn = N >> 8, ntiles = (K >> 6) * ntn;
        for (int tile = (int)gridDim.x - 1 - (int)blockIdx.x; tile < ntiles; tile += gridDim.x) {
            const int k0 = (tile / ntn) << 6, n0 = (tile % ntn) << 8;
            f32x4 v[8];
#pragma unroll
            for (int i = 0; i < 8; ++i) {
                const int row = (tid >> 4) + 32 * (i & 1), col4 = (i >> 1) * 64 + (tid & 15) * 4;
                v[i] = *(const f32x4*)(W + (size_t)(k0 + row) * N + n0 + col4);
            }
#pragma unroll
            for (int i = 0; i < 8; ++i) {
                const int row = (tid >> 4) + 32 * (i & 1), c4 = (tid & 15) * 4;
                LAS u16* t = sT + (i >> 1) * 4608;
                t[(c4 + 0) * 72 + row] = f2bf(v[i][0]); t[(c4 + 1) * 72 + row] = f2bf(v[i][1]);
                t[(c4 + 2) * 72 + row] = f2bf(v[i][2]); t[(c4 + 3) * 72 + row] = f2bf(v[i][3]);
            }
            __syncthreads();
            const int n = tid >> 3, ks = (tid & 7) * 8;
#pragma unroll
            for (int sub = 0; sub < 4; ++sub) {
                const bf16x8 o = *(const LAS bf16x8*)(sT + sub * 4608 + n * 72 + ks);
                *(bf16x8*)(WT + (size_t)perm_col(kind, n0 + sub * 64 + n) * K + k0 + ks) = o;
            }
            __syncthreads();
        }
    }
    for (int gt = (int)gridDim.x - 1 - (int)blockIdx.x; gt < 256; gt += gridDim.x) {
        const int mat = gt >> 3, t8 = gt & 7, k0 = (t8 >> 1) << 6, n0 = (t8 & 1) << 8;
        const float* W = ((mat >> 4) ? p->in[5] : p->in[4]) + (size_t)(mat & 15) * 131072;
        u16* WT = (u16*)(p->ws + UR_SB) + (size_t)mat * 131072;
        f32x4 v[8];
#pragma unroll
        for (int i = 0; i < 8; ++i) {
            const int row = (tid >> 4) + 32 * (i & 1), col4 = (i >> 1) * 64 + (tid & 15) * 4;
            v[i] = *(const f32x4*)(W + (size_t)(k0 + row) * 512 + n0 + col4);
        }
#pragma unroll
        for (int i = 0; i < 8; ++i) {
            const int row = (tid >> 4) + 32 * (i & 1), c4 = (tid & 15) * 4;
            LAS u16* t = sT + (i >> 1) * 4608;
            t[(c4 + 0) * 72 + row] = f2bf(v[i][0]); t[(c4 + 1) * 72 + row] = f2bf(v[i][1]);
            t[(c4 + 2) * 72 + row] = f2bf(v[i][2]); t[(c4 + 3) * 72 + row] = f2bf(v[i][3]);
        }
        __syncthreads();
        const int n = tid >> 3, ks = (tid & 7) * 8;
#pragma unroll
        for (int sub = 0; sub < 4; ++sub) {
            const bf16x8 o = *(const LAS bf16x8*)(sT + sub * 4608 + n * 72 + ks);
            *(bf16x8*)(WT + (size_t)(n0 + sub * 64 + n) * 256 + k0 + ks) = o;
        }
        __syncthreads();
    }
    for (int e = blockIdx.x * NTHREADS + tid; e < 32768; e += gridDim.x * NTHREADS) {
        const int t = e >> 5, dd = e & 31, f = dd & 15;
        const float inv = exp2f(-(float)f * (13.287712379549449f / 16.0f));
        const float pos = (dd < 16) ? (float)(t >> 6) : (float)(t & 63);
        const float ang = pos * inv;
        float* o = (float*)(p->ws + WS_ROPE) + (size_t)e * 2;
        o[0] = cosf(ang); o[1] = sinf(ang);
    }
}

__device__ __forceinline__ void cache_convert(int wv, KP p, int j) {
    const int gt = blockIdx.x * NTHREADS + tid_l(wv), gs = gridDim.x * NTHREADS;
    for (int idx = gt; idx < 4 * 256 * 8 * 16; idx += gs) {
        const int d8 = idx & 15, h = (idx >> 4) & 7, s = (idx >> 7) & 255, b = idx >> 15;
        const float* src = p->in[2] + ((size_t)((b * 2 + j) * 256 + s) * 8 + h) * 128 + d8 * 8;
        const f32x4 v0 = *(const f32x4*)src, v1 = *(const f32x4*)(src + 4);
        const int mm = d8 >> 3, d = (d8 & 7) * 8;
        u16* dst = (u16*)(p->ws + UA_KL) + ((size_t)((b * 8 + h) * 2 + mm) * 1280 + 1024 + s) * 64 + d;
        pg8::u32x4 o; o.x = pk2(v0[0], v0[1]); o.y = pk2(v0[2], v0[3]); o.z = pk2(v1[0], v1[1]); o.w = pk2(v1[2], v1[3]);
        *(pg8::u32x4*)dst = o;
    }
    for (int idx = gt; idx < 4 * 256 * 8 * 16; idx += gs) {
        const int s = idx & 255, d8 = (idx >> 8) & 15, h = (idx >> 12) & 7, b = idx >> 15;
        const float* src = p->in[3] + ((size_t)((b * 2 + j) * 256 + s) * 8 + h) * 128 + d8 * 8;
        const f32x4 v0 = *(const f32x4*)src, v1 = *(const f32x4*)(src + 4);
        u16* dst = (u16*)(p->ws + UA_VTL) + ((size_t)(b * 8 + h) * 128 + d8 * 8) * 1280 + 1024 + s;
        dst[0] = f2bf(v0[0]); dst[1280] = f2bf(v0[1]); dst[2560] = f2bf(v0[2]); dst[3840] = f2bf(v0[3]);
        dst[5120] = f2bf(v1[0]); dst[6400] = f2bf(v1[1]); dst[7680] = f2bf(v1[2]); dst[8960] = f2bf(v1[3]);
    }
}

__device__ __forceinline__ void phase_p0b(int wv, KP p) {
    const float* mod = (const float*)(p->ws + WS_MOD);
    u16* A = (u16*)(p->ws + WS_ABUF);
    for (int idx = blockIdx.x * NTHREADS + tid_l(wv); idx < 8192 * 128; idx += gridDim.x * NTHREADS) {
        const int r = idx >> 7, c = (idx & 127) * 8;
        const float* x = (r < 4096) ? p->in[0] + (size_t)r * 1024 + c : p->in[1] + (size_t)(r - 4096) * 1024 + c;
        const float* md = mod + (size_t)row_n5(r) * 3072;
        const f32x4 x0 = *(const f32x4*)x, x1 = *(const f32x4*)(x + 4);
        const f32x4 sh0 = *(const f32x4*)(md + c), sh1 = *(const f32x4*)(md + c + 4), sc0 = *(const f32x4*)(md + 1024 + c), sc1 = *(const f32x4*)(md + 1024 + c + 4);
        const f32x4 h0 = x0 * (sc0 + 1.0f) + sh0, h1 = x1 * (sc1 + 1.0f) + sh1;
        pg8::u32x4 o; o.x = pk2(h0[0], h0[1]); o.y = pk2(h0[2], h0[3]); o.z = pk2(h1[0], h1[1]); o.w = pk2(h1[2], h1[3]);
        *(pg8::u32x4*)(A + (size_t)r * 1024 + c) = o;
    }
}

__device__ __forceinline__ void phase_ln(int wv, KP p, int li, int nxt, bool dry = false) {
    const int tid = tid_l(wv), w = tid >> 6, lane = tid & 63;
    const float* g = p->in[10] + li * 1024; const float* bb = p->in[11] + li * 1024;
    u16* A = (u16*)(p->ws + (dry ? UR_G : WS_ABUF));
    const int nw = gridDim.x * 8;
    for (int r = blockIdx.x * 8 + w; r < 4096; r += nw) {
        f32x4 v[2][4];
        float s[2] = {0.f, 0.f};
#pragma unroll
        for (int h = 0; h < 2; ++h) {
            const float* x = p->out + (size_t)(r + h * 4096) * 1024;
            const float* x2 = (const float*)(p->ws + WS_X2) + (size_t)(r + h * 4096) * 1024;
#pragma unroll
            for (int q = 0; q < 4; ++q) { v[h][q] = *(const f32x4*)(x + q * 256 + lane * 4) + *(const f32x4*)(x2 + q * 256 + lane * 4); s[h] += v[h][q][0] + v[h][q][1] + v[h][q][2] + v[h][q][3]; }
        }
#pragma unroll
        for (int o = 32; o; o >>= 1) { s[0] += shx(s[0], o, lane); s[1] += shx(s[1], o, lane); }
        float ss[2] = {0.f, 0.f};
#pragma unroll
        for (int h = 0; h < 2; ++h) {
            const float mu = s[h] * (1.0f / 1024.0f);
#pragma unroll
            for (int q = 0; q < 4; ++q) { v[h][q] = v[h][q] - mu; ss[h] += v[h][q][0] * v[h][q][0] + v[h][q][1] * v[h][q][1] + v[h][q][2] * v[h][q][2] + v[h][q][3] * v[h][q][3]; }
        }
#pragma unroll
        for (int o = 32; o; o >>= 1) { ss[0] += shx(ss[0], o, lane); ss[1] += shx(ss[1], o, lane); }
#pragma unroll
        for (int h = 0; h < 2; ++h) {
            const int rr = r + h * 4096;
            const float rstd = rsqrtf(ss[h] * (1.0f / 1024.0f) + 1e-5f);
            const float* md = (const float*)(p->ws + WS_MOD) + ((size_t)(nxt < 4 ? nxt : 0) * 5 + row_n5(rr)) * 3072;
            float* xo = dry ? (float*)(p->ws + UR_O) + (size_t)rr * 1024 : p->out + (size_t)rr * 1024;
#pragma unroll
            for (int q = 0; q < 4; ++q) {
                const int c = q * 256 + lane * 4;
                const f32x4 xn = v[h][q] * rstd * *(const f32x4*)(g + c) + *(const f32x4*)(bb + c);
                *(f32x4*)(xo + c) = xn;
                if (nxt < 4) {
                    const f32x4 hh = xn * (*(const f32x4*)(md + 1024 + c) + 1.0f) + *(const f32x4*)(md + c);
                    *(u32x2*)(A + (size_t)rr * 1024 + c) = pk4(hh);
                }
            }
        }
    }
}

__device__ __forceinline__ void phase_attn(int wv, KP p, int j, LAS unsigned char* lds) {
    const int tid = tid_l(wv), w = tid >> 6, lane = tid & 63, lr = lane & 15, lq = lane >> 4;
    LAS u16* sm = (LAS u16*)lds;
    float la = p->in[13][j * 256 + lane] * p->in[13][j * 256 + 64 + lane], lb = p->in[13][j * 256 + 128 + lane] * p->in[13][j * 256 + 192 + lane];
#pragma unroll
    for (int o = 32; o; o >>= 1) { la += shx(la, o, lane); lb += shx(lb, o, lane); }
    const float lam_init = p->lam_init[j];
    const float lamv = __expf(la) - __expf(lb) + lam_init;
    const float* subln = p->in[14] + j * 128;
    const u16* Q = (const u16*)(p->ws + UA_Q);
    const u16* Z = (const u16*)(p->ws + UA_Z);
    u16* A = (u16*)(p->ws + WS_ABUF);
    const float SC = 0.125f * LOG2E;
    for (int it0 = blockIdx.x; it0 < 512; it0 += gridDim.x) {
        const int it = (it0 & ~255) | ((it0 & 7) << 5) | ((it0 & 255) >> 3);
        int b, h, r0, nkeys; const u16* Kb; const u16* Vb;
        if (it < 256) { b = it >> 6; h = (it >> 3) & 7; r0 = 4096 + b * 1024 + (it & 7) * 128; nkeys = 1280;
            Kb = (const u16*)(p->ws + UA_KL) + (size_t)(b * 8 + h) * 2 * 1280 * 64; Vb = (const u16*)(p->ws + UA_VTL) + (size_t)(b * 8 + h) * 128 * 1280; }
        else { const int i2 = it - 256; b = i2 >> 4; h = (i2 >> 1) & 7; r0 = b * 256 + (i2 & 1) * 128; nkeys = 256;
            Kb = (const u16*)(p->ws + UA_KC) + (size_t)(b * 8 + h) * 2 * 256 * 64; Vb = (const u16*)(p->ws + UA_VTC) + (size_t)(b * 8 + h) * 128 * 256; }
        const int row_a = r0 + w * 16 + lr;
        bf16x8 qf[2][2];
#pragma unroll
        for (int m = 0; m < 2; ++m)
#pragma unroll
            for (int ks = 0; ks < 2; ++ks) qf[m][ks] = *(const bf16x8*)(Q + (size_t)row_a * 1024 + h * 128 + m * 64 + ks * 32 + lq * 8);
        f32x4 O[2][8];
        float mrow[2], lsum[2];
#pragma unroll
        for (int m = 0; m < 2; ++m) {
#pragma unroll
            for (int n = 0; n < 8; ++n) O[m][n] = (f32x4){0.f, 0.f, 0.f, 0.f};
            mrow[m] = -1e30f; lsum[m] = 0.f;
        }
        const int ntiles = nkeys >> 6;
        const int krow = tid >> 3, kseg = (tid & 7) * 8, vrow = tid >> 2, vseg = (tid & 3) * 16;
        bf16x8 g0, g1, g2, g3;
        g0 = *(const bf16x8*)(Kb + (size_t)krow * 64 + kseg);
        g1 = *(const bf16x8*)(Kb + (size_t)(nkeys + krow) * 64 + kseg);
        g2 = *(const bf16x8*)(Vb + (size_t)vrow * nkeys + vseg);
        g3 = *(const bf16x8*)(Vb + (size_t)vrow * nkeys + vseg + 8);
        *(LAS bf16x8*)(sm + krow * 72 + kseg) = g0; *(LAS bf16x8*)(sm + 4608 + krow * 72 + kseg) = g1;
        *(LAS bf16x8*)(sm + 9216 + vrow * 72 + vseg) = g2; *(LAS bf16x8*)(sm + 9216 + vrow * 72 + vseg + 8) = g3;
        __syncthreads();
        for (int kt = 0; kt < ntiles; ++kt) {
            const int cur = kt & 1;
            const bool more = kt + 1 < ntiles;
            if (more) {
                const int k0 = (kt + 1) * 64;
                g0 = *(const bf16x8*)(Kb + (size_t)(k0 + krow) * 64 + kseg);
                g1 = *(const bf16x8*)(Kb + (size_t)(nkeys + k0 + krow) * 64 + kseg);
                g2 = *(const bf16x8*)(Vb + (size_t)vrow * nkeys + k0 + vseg);
                g3 = *(const bf16x8*)(Vb + (size_t)vrow * nkeys + k0 + vseg + 8);
            }
            const LAS u16* bK = sm + cur * 18432; const LAS u16* bV = bK + 9216;
            f32x4 s[2][4];
#pragma unroll
            for (int m = 0; m < 2; ++m)
#pragma unroll
                for (int n = 0; n < 4; ++n) s[m][n] = (f32x4){0.f, 0.f, 0.f, 0.f};
#pragma unroll
            for (int m = 0; m < 2; ++m)
#pragma unroll
                for (int ks = 0; ks < 2; ++ks)
#pragma unroll
                    for (int n = 0; n < 4; ++n) {
                        const bf16x8 kf = *(const LAS bf16x8*)(bK + m * 4608 + (n * 16 + lr) * 72 + ks * 32 + lq * 8);
                        s[m][n] = MFMA16(kf, qf[m][ks], s[m][n]);
                    }
            bf16x8 pf[2][2];
#pragma unroll
            for (int m = 0; m < 2; ++m) {
                float mx = -1e30f;
#pragma unroll
                for (int n = 0; n < 4; ++n)
#pragma unroll
                    for (int i = 0; i < 4; ++i) { s[m][n][i] *= SC; mx = fmaxf(mx, s[m][n][i]); }
                mx = fmaxf(mx, shx(mx, 16, lane)); mx = fmaxf(mx, shx(mx, 32, lane));
                const float mn = fmaxf(mrow[m], mx);
                const float al = ex2(mrow[m] - mn);
                mrow[m] = mn;
                if (__builtin_amdgcn_ballot_w64(al != 1.0f) != 0ull) {
#pragma unroll
                    for (int n = 0; n < 8; ++n) O[m][n] = O[m][n] * al;
                }
                float ls = 0.f;
#pragma unroll
                for (int n = 0; n < 4; ++n)
#pragma unroll
                    for (int i = 0; i < 4; ++i) { s[m][n][i] = ex2(s[m][n][i] - mn); ls += s[m][n][i]; }
                lsum[m] = lsum[m] * al + ls;
#pragma unroll
                for (int k2 = 0; k2 < 2; ++k2) {
                    pg8::u32x4 pk; pk.x = pk2(s[m][2 * k2][0], s[m][2 * k2][1]); pk.y = pk2(s[m][2 * k2][2], s[m][2 * k2][3]);
                    pk.z = pk2(s[m][2 * k2 + 1][0], s[m][2 * k2 + 1][1]); pk.w = pk2(s[m][2 * k2 + 1][2], s[m][2 * k2 + 1][3]);
                    pf[m][k2] = __builtin_bit_cast(bf16x8, pk);
                }
            }
#pragma unroll
            for (int k2 = 0; k2 < 2; ++k2)
#pragma unroll
                for (int n = 0; n < 8; ++n) {
                    const u32x2 va = *(const LAS u32x2*)(bV + (n * 16 + lr) * 72 + k2 * 32 + lq * 4);
                    const u32x2 vb = *(const LAS u32x2*)(bV + (n * 16 + lr) * 72 + k2 * 32 + 16 + lq * 4);
                    pg8::u32x4 vv; vv.x = va.x; vv.y = va.y; vv.z = vb.x; vv.w = vb.y;
                    const bf16x8 vf = __builtin_bit_cast(bf16x8, vv);
                    O[0][n] = MFMA16(vf, pf[0][k2], O[0][n]);
                    O[1][n] = MFMA16(vf, pf[1][k2], O[1][n]);
                }
            if (more) {
                LAS u16* nb = sm + (cur ^ 1) * 18432;
                *(LAS bf16x8*)(nb + krow * 72 + kseg) = g0; *(LAS bf16x8*)(nb + 4608 + krow * 72 + kseg) = g1;
                *(LAS bf16x8*)(nb + 9216 + vrow * 72 + vseg) = g2; *(LAS bf16x8*)(nb + 9216 + vrow * 72 + vseg + 8) = g3;
            }
            __syncthreads();
        }
        float l0 = lsum[0], l1 = lsum[1];
        l0 += shx(l0, 16, lane); l0 += shx(l0, 32, lane);
        l1 += shx(l1, 16, lane); l1 += shx(l1, 32, lane);
        const float i0 = 1.0f / l0, i1 = lamv / l1;
        float ss = 0.f;
#pragma unroll
        for (int n = 0; n < 8; ++n) {
            O[0][n] = O[0][n] * i0 - O[1][n] * i1;
            ss += O[0][n][0] * O[0][n][0] + O[0][n][1] * O[0][n][1] + O[0][n][2] * O[0][n][2] + O[0][n][3] * O[0][n][3];
        }
        ss += shx(ss, 16, lane); ss += shx(ss, 32, lane);
        const float rstd = rsqrtf(ss * (1.0f / 128.0f) + 1e-6f) * (1.0f - lam_init);
#pragma unroll
        for (int n = 0; n < 8; ++n) {
            const int dv = n * 16 + lq * 4;
            const size_t off = (size_t)row_a * 1024 + h * 128 + dv;
            const u32x2 zz = *(const u32x2*)(Z + off);
            const f32x4 sg = *(const f32x4*)(subln + dv);
            f32x4 o;
            o[0] = O[0][n][0] * rstd * sg[0] * bf2f((u16)(zz.x & 0xffffu)); o[1] = O[0][n][1] * rstd * sg[1] * bf2f((u16)(zz.x >> 16));
            o[2] = O[0][n][2] * rstd * sg[2] * bf2f((u16)(zz.y & 0xffffu)); o[3] = O[0][n][3] * rstd * sg[3] * bf2f((u16)(zz.y >> 16));
            *(u32x2*)(A + off) = pk4(o);
        }
    }
}

__device__ __forceinline__ void phase_ret(int wv, KP p, LAS unsigned char* lds) {
    LAS u16* sm = (LAS u16*)lds;
    const u16* QR = (const u16*)(p->ws + UR_QR); const u16* KR = (const u16*)(p->ws + UR_KR);
    const u16* KTR = (const u16*)(p->ws + UR_KTR); const u16* VTR = (const u16*)(p->ws + UR_VTR);
    const u16* S0T = (const u16*)(p->ws + UR_SB);
    u16* OB = (u16*)(p->ws + UR_O);
    for (int it0 = blockIdx.x; it0 < 512; it0 += gridDim.x) {
        const int it = (it0 & ~255) | ((it0 & 7) << 5) | ((it0 & 255) >> 3);
        const int tid = tid_l(wv), w = tid >> 6, lane = tid & 63, lr = lane & 15, lq = lane >> 4;
        const bool lat = it < 256;
        int b, h, qt, dvs, r0, T;
        if (lat) { b = it >> 6; h = (it >> 4) & 3; qt = (it >> 2) & 3; dvs = it & 3; r0 = 4096 + b * 1024; T = 1024; }
        else { const int i2 = it - 256; b = i2 >> 4; h = (i2 >> 2) & 3; qt = 0; dvs = i2 & 3; r0 = b * 256; T = 256; }
        const float lgf2 = log1pf(-expf(p->in[17][h])) * LOG2E, lgb2 = log1pf(-expf(p->in[18][h])) * LOG2E;
        const int nkey = T >> 6, nsteps = lat ? nkey + 8 : nkey;
        const int qpos0 = qt * 256 + w * 32 + lr;
        const size_t qrow0 = (size_t)(r0 + qpos0);
        bf16x8 qf[2][8];
#pragma unroll
        for (int st2 = 0; st2 < 2; ++st2)
#pragma unroll
            for (int ks = 0; ks < 8; ++ks) qf[st2][ks] = *(const bf16x8*)(QR + (qrow0 + st2 * 16) * 1024 + h * 256 + ks * 32 + lq * 8);
        f32x4 O[2][8];
#pragma unroll
        for (int st2 = 0; st2 < 2; ++st2)
#pragma unroll
            for (int n = 0; n < 8; ++n) O[st2][n] = (f32x4){0.f, 0.f, 0.f, 0.f};
        const u16* kbase = KR + (size_t)r0 * 1024 + h * 256;
        const u16* vbase = VTR + (size_t)(h * 512 + dvs * 128) * 8192 + r0;
        const u16* sbase = S0T + (size_t)(b * 4 + h) * 131072 + (size_t)(dvs * 128) * 256;
        bf16x8 gk[4], gv[2];
#define RET_ISSUE(st) do { int tvv = tid; asm volatile("" : "+v"(tvv)); \
            if ((st) < nkey) { \
                _Pragma("unroll") for (int k = 0; k < 4; ++k) { const int idx = tvv + k * 512; \
                    gk[k] = *(const bf16x8*)(kbase + (size_t)((st) * 64 + (idx >> 5)) * 1024 + (idx & 31) * 8); } \
                _Pragma("unroll") for (int k = 0; k < 2; ++k) { const int idx = tvv + k * 512; \
                    gv[k] = *(const bf16x8*)(vbase + (size_t)(idx >> 3) * 8192 + (st) * 64 + (idx & 7) * 8); } \
            } else { const int s2 = (st) - nkey; const u16* sb = sbase + (size_t)(s2 >> 2) * 16 * 131072 + (s2 & 3) * 64; \
                _Pragma("unroll") for (int k = 0; k < 2; ++k) { const int idx = tvv + k * 512; \
                    gv[k] = *(const bf16x8*)(sb + (size_t)(idx >> 3) * 256 + (idx & 7) * 8); } } } while (0)
#define RET_COMMIT(st, buf) do { LAS u16* bb = sm + (buf) * 26112; int tvv = tid; asm volatile("" : "+v"(tvv)); \
            if ((st) < nkey) { _Pragma("unroll") for (int k = 0; k < 4; ++k) { const int idx = tvv + k * 512; \
                    *(LAS bf16x8*)(bb + (idx >> 5) * 264 + (idx & 31) * 8) = gk[k]; } } \
            _Pragma("unroll") for (int k = 0; k < 2; ++k) { const int idx = tvv + k * 512; \
                    *(LAS bf16x8*)(bb + 16896 + (idx >> 3) * 72 + (idx & 7) * 8) = gv[k]; } } while (0)
        RET_ISSUE(0);
        __syncthreads();
        RET_COMMIT(0, 0);
        __syncthreads();
        for (int st = 0; st < nsteps; ++st) {
            const int cur = st & 1;
            const bool more = st + 1 < nsteps;
            if (more) RET_ISSUE(st + 1);
            const LAS u16* bK = sm + cur * 26112; const LAS u16* bV = bK + 16896;
            float lf = lgf2, lb = lgb2; int lqv = lq, qpv = qpos0; asm volatile("" : "+v"(lf), "+v"(lb), "+v"(lqv), "+v"(qpv));
            if (st < nkey) {
#pragma unroll
                for (int k2 = 0; k2 < 2; ++k2) {
                    f32x4 s4[2][2];
#pragma unroll
                    for (int st2 = 0; st2 < 2; ++st2) { s4[st2][0] = (f32x4){0.f, 0.f, 0.f, 0.f}; s4[st2][1] = (f32x4){0.f, 0.f, 0.f, 0.f}; }
#pragma unroll
                    for (int ks = 0; ks < 8; ++ks)
#pragma unroll
                        for (int n = 0; n < 2; ++n) {
                            const bf16x8 kf = *(const LAS bf16x8*)(bK + ((2 * k2 + n) * 16 + lr) * 264 + ks * 32 + lq * 8);
                            s4[0][n] = MFMA16(kf, qf[0][ks], s4[0][n]);
                            s4[1][n] = MFMA16(kf, qf[1][ks], s4[1][n]);
                        }
                    bf16x8 pf[2];
#pragma unroll
                    for (int st2 = 0; st2 < 2; ++st2) {
#pragma unroll
                        for (int n = 0; n < 2; ++n)
#pragma unroll
                            for (int i = 0; i < 4; ++i) {
                                const int df = qpv + st2 * 16 - (st * 64 + (2 * k2 + n) * 16 + lqv * 4 + i);
                                const float e = ex2((df > 0 ? lf : -lb) * (float)df);
                                s4[st2][n][i] *= (df == 0) ? 2.0f : e;
                            }
                        pg8::u32x4 pk; pk.x = pk2(s4[st2][0][0], s4[st2][0][1]); pk.y = pk2(s4[st2][0][2], s4[st2][0][3]);
                        pk.z = pk2(s4[st2][1][0], s4[st2][1][1]); pk.w = pk2(s4[st2][1][2], s4[st2][1][3]);
                        pf[st2] = __builtin_bit_cast(bf16x8, pk);
                    }
#pragma unroll
                    for (int n = 0; n < 8; ++n) {
                        const u32x2 va = *(const LAS u32x2*)(bV + (n * 16 + lr) * 72 + k2 * 32 + lq * 4);
                        const u32x2 vb = *(const LAS u32x2*)(bV + (n * 16 + lr) * 72 + k2 * 32 + 16 + lq * 4);
                        pg8::u32x4 vv; vv.x = va.x; vv.y = va.y; vv.z = vb.x; vv.w = vb.y;
                        const bf16x8 vf = __builtin_bit_cast(bf16x8, vv);
                        O[0][n] = MFMA16(vf, pf[0], O[0][n]);
                        O[1][n] = MFMA16(vf, pf[1], O[1][n]);
                    }
                }
            } else {
                const int s2 = st - nkey, dt = s2 & 3;
#pragma unroll
                for (int k2 = 0; k2 < 2; ++k2) {
                    bf16x8 qs[2];
#pragma unroll
                    for (int st2 = 0; st2 < 2; ++st2) {
                        const float qd = (s2 < 4) ? ex2(lf * (float)(qpv + st2 * 16 + 1)) : ex2(lb * (float)(T - qpv - st2 * 16));
                        bf16x8 qsrc = qf[st2][0];
#pragma unroll
                        for (int ks = 0; ks < 8; ++ks) if (ks == dt * 2 + k2) qsrc = qf[st2][ks];
                        const pg8::u32x4 qu = __builtin_bit_cast(pg8::u32x4, qsrc);
                        pg8::u32x4 qo;
                        qo.x = pk2(__uint_as_float(qu.x << 16) * qd, __uint_as_float(qu.x & 0xffff0000u) * qd);
                        qo.y = pk2(__uint_as_float(qu.y << 16) * qd, __uint_as_float(qu.y & 0xffff0000u) * qd);
                        qo.z = pk2(__uint_as_float(qu.z << 16) * qd, __uint_as_float(qu.z & 0xffff0000u) * qd);
                        qo.w = pk2(__uint_as_float(qu.w << 16) * qd, __uint_as_float(qu.w & 0xffff0000u) * qd);
                        qs[st2] = __builtin_bit_cast(bf16x8, qo);
                    }
#pragma unroll
                    for (int n = 0; n < 8; ++n) {
                        const bf16x8 sf = *(const LAS bf16x8*)(bV + (n * 16 + lr) * 72 + k2 * 32 + lq * 8);
                        O[0][n] = MFMA16(sf, qs[0], O[0][n]);
                        O[1][n] = MFMA16(sf, qs[1], O[1][n]);
                    }
                }
            }
            if (more) RET_COMMIT(st + 1, cur ^ 1);
            __syncthreads();
        }
#pragma unroll
        for (int st2 = 0; st2 < 2; ++st2)
#pragma unroll
            for (int n = 0; n < 8; ++n)
                *(u32x2*)(OB + (qrow0 + st2 * 16) * 2048 + h * 512 + dvs * 128 + n * 16 + lq * 4) = pk4(O[st2][n]);
    }
#undef RET_ISSUE
#undef RET_COMMIT
    for (int it = blockIdx.x; it < 512; it += gridDim.x) {
        const int tid = tid_l(wv), w = tid >> 6, lane = tid & 63, lr = lane & 15, lq = lane >> 4;
        const int b = it >> 5, h = (it >> 3) & 3, ds = it & 7, r0 = b * 256;
        const float lgf2 = log1pf(-expf(p->in[17][h])) * LOG2E, lgb2 = log1pf(-expf(p->in[18][h])) * LOG2E;
        LAS u16* vF = sm; LAS u16* vB = sm + 16896;
        int tv = tid; asm volatile("" : "+v"(tv));
        __syncthreads();
#pragma unroll 1
        for (int k = 0; k < 4; ++k) {
            const int idx = tv + k * 512, row = idx >> 5, seg = idx & 31;
            const bf16x8 v = *(const bf16x8*)(VTR + (size_t)(h * 512 + ds * 64 + row) * 8192 + r0 + seg * 8);
            const pg8::u32x4 vu = __builtin_bit_cast(pg8::u32x4, v);
            float f[8];
            f[0] = __uint_as_float(vu.x << 16); f[1] = __uint_as_float(vu.x & 0xffff0000u); f[2] = __uint_as_float(vu.y << 16); f[3] = __uint_as_float(vu.y & 0xffff0000u);
            f[4] = __uint_as_float(vu.z << 16); f[5] = __uint_as_float(vu.z & 0xffff0000u); f[6] = __uint_as_float(vu.w << 16); f[7] = __uint_as_float(vu.w & 0xffff0000u);
            pg8::u32x4 of, ob;
            float df[8], db[8];
#pragma unroll
            for (int q = 0; q < 8; ++q) { const int m = seg * 8 + q; df[q] = f[q] * ex2(lgf2 * (float)(255 - m)); db[q] = f[q] * ex2(lgb2 * (float)m); }
            of.x = pk2(df[0], df[1]); of.y = pk2(df[2], df[3]); of.z = pk2(df[4], df[5]); of.w = pk2(df[6], df[7]);
            ob.x = pk2(db[0], db[1]); ob.y = pk2(db[2], db[3]); ob.z = pk2(db[4], db[5]); ob.w = pk2(db[6], db[7]);
            *(LAS pg8::u32x4*)(vF + row * 264 + seg * 8) = of;
            *(LAS pg8::u32x4*)(vB + row * 264 + seg * 8) = ob;
        }
        __syncthreads();
        f32x4 SF[4][2], SBk[4][2];
#pragma unroll
        for (int n = 0; n < 4; ++n)
#pragma unroll
            for (int c = 0; c < 2; ++c) { SF[n][c] = (f32x4){0.f, 0.f, 0.f, 0.f}; SBk[n][c] = (f32x4){0.f, 0.f, 0.f, 0.f}; }
        const u16* ktw = KTR + (size_t)(h * 256 + w * 32 + lr) * 8192 + r0 + lq * 8;
#pragma unroll
        for (int half = 0; half < 2; ++half) {
            bf16x8 kf[4][2];
#pragma unroll
            for (int k4 = 0; k4 < 4; ++k4)
#pragma unroll
                for (int c = 0; c < 2; ++c) kf[k4][c] = *(const bf16x8*)(ktw + (size_t)c * 16 * 8192 + (half * 4 + k4) * 32);
#pragma unroll
            for (int k4 = 0; k4 < 4; ++k4)
#pragma unroll
                for (int n = 0; n < 4; ++n) {
                    const bf16x8 a = *(const LAS bf16x8*)(vF + (n * 16 + lr) * 264 + (half * 4 + k4) * 32 + lq * 8);
                    const bf16x8 bb = *(const LAS bf16x8*)(vB + (n * 16 + lr) * 264 + (half * 4 + k4) * 32 + lq * 8);
#pragma unroll
                    for (int c = 0; c < 2; ++c) { SF[n][c] = MFMA16(a, kf[k4][c], SF[n][c]); SBk[n][c] = MFMA16(bb, kf[k4][c], SBk[n][c]); }
                }
        }
        const size_t st_off = (size_t)(b * 4 + h) * 131072 + ds * 64;
#pragma unroll
        for (int n = 0; n < 4; ++n)
#pragma unroll
            for (int c = 0; c < 2; ++c) {
                const size_t o = st_off + (size_t)(w * 32 + c * 16 + lr) * 512 + n * 16 + lq * 4;
                *(f32x4*)(p->out + OUT_NSF + o) = SF[n][c];
                *(f32x4*)(p->out + OUT_NSB + o) = SBk[n][c];
            }
    }
}

__device__ __forceinline__ void phase_retfin(int wv, KP p) {
    const int tid = tid_l(wv), w = tid >> 6, lane = tid & 63;
    const u16* OB = (const u16*)(p->ws + UR_O); const u16* Gb = (const u16*)(p->ws + UR_G);
    u16* A2 = (u16*)(p->ws + UR_QR);
    for (int rh = blockIdx.x * 8 + w; rh < 8192 * 4; rh += gridDim.x * 8) {
        const size_t off = (size_t)(rh >> 2) * 2048 + (rh & 3) * 512 + lane * 8;
        const bf16x8 o = *(const bf16x8*)(OB + off), g = *(const bf16x8*)(Gb + off);
        float of[8]; float ss = 0.f;
#pragma unroll
        for (int q = 0; q < 8; ++q) { of[q] = bf2f((u16)o[q]); ss += of[q] * of[q]; }
#pragma unroll
        for (int s = 32; s; s >>= 1) ss += shx(ss, s, lane);
        const float rstd = rsqrtf(ss * (1.0f / 512.0f) + 1e-6f);
        bf16x8 a;
#pragma unroll
        for (int q = 0; q < 8; ++q) a[q] = (short)f2bf(of[q] * rstd * bf2f((u16)g[q]));
        *(bf16x8*)(A2 + off) = a;
    }
}

__device__ __forceinline__ void phase_convfin(int wv, KP p) {
    const u16* T1 = (const u16*)(p->ws + UC_T1); const u16* PC = (const u16*)(p->ws + UC_PC);
    u16* A = (u16*)(p->ws + WS_ABUF);
    const float* cw = p->in[21];
    for (int idx = blockIdx.x * NTHREADS + tid_l(wv); idx < 8192 * 128; idx += gridDim.x * NTHREADS) {
        const int r = idx >> 7, e = (idx & 127) * 8;
        const int t = r < 4096 ? (r & 255) : (r & 1023), T = r < 4096 ? 256 : 1024;
        const size_t off = (size_t)r * 1024 + e;
        const bf16x8 t1 = *(const bf16x8*)(T1 + off), pc = *(const bf16x8*)(PC + off);
        bf16x8 pp, pn;
#pragma unroll
        for (int q = 0; q < 8; ++q) { pp[q] = 0; pn[q] = 0; }
        if (t > 0) pp = *(const bf16x8*)(PC + off - 1024);
        if (t < T - 1) pn = *(const bf16x8*)(PC + off + 1024);
        bf16x8 a;
#pragma unroll
        for (int q = 0; q < 8; ++q) {
            const float cv = cw[e + q] * bf2f((u16)pp[q]) + cw[1024 + e + q] * bf2f((u16)pc[q]) + cw[2048 + e + q] * bf2f((u16)pn[q]);
            a[q] = (short)f2bf(bf2f((u16)t1[q]) * cv);
        }
        *(bf16x8*)(A + off) = a;
    }
}

#define XBAR(xb) do { _Pragma("nounroll") for (int _r = 0; _r < REP_BAR; ++_r) xcd_barrier(xb); } while (0)
__global__ void __launch_bounds__(512) mega(Prm p_unused) {
    const KP kp = (KP)__builtin_amdgcn_kernarg_segment_ptr();
    extern __shared__ __attribute__((aligned(16))) unsigned char shm[];
    LAS unsigned char* lds = (LAS unsigned char*)shm;
    cg::grid_group grid = cg::this_grid();
    pg8::StaticOrder S;
    const int wv = __builtin_amdgcn_readfirstlane((int)(threadIdx.x >> 6));
    S.wv = wv;
    volatile LAS unsigned* xst = (volatile LAS unsigned*)(lds + LDS_MAIN);
    if (xb_first(wv)) { xst[0] = 0u; xst[1] = 0u; xst[2] = 0u; xst[3] = 0u; }
    __syncthreads();
    XcdBarrier xb = xcd_barrier_post((unsigned*)(kp->ws + WS_BAR), xst, wv);
#pragma nounroll
    for (int rep = 0; rep < REP_P0A; ++rep) phase_p0a(wv, lp(kp), lds);
    if (gridDim.x == 0x7fffffffu) grid.sync();
    XBAR(xb);
#pragma nounroll
    for (int rep = 0; rep < REP_EW; ++rep) { phase_p0b(wv, lp(kp)); cache_convert(wv, lp(kp), 0); }
    XBAR(xb);
    for (int li = 0; li < 4; ++li) {
        const int kind = li % 3, j = li / 3;
        const KP p = lp(kp);
        {
            pg8::Gemm g; g.A = (const u16*)(p->ws + WS_ABUF); g.M = 8192; g.K = 1024; g.KL = 1024;
            if (kind == 0) { g.Bt = (const u16*)(p->ws + (j == 0 ? WS_WT_A0 : WS_WT_A1)); g.N = 4096; }
            else if (kind == 1) { g.Bt = (const u16*)(p->ws + WS_WT_B); g.N = 6144; }
            else { g.Bt = (const u16*)(p->ws + WS_WT_C); g.N = 4096; }
            Epi E; E.kind = kind; E.layer = li; E.j = j; E.p = lp(kp);
            S.init(g.M, g.N, (int)gridDim.x, (int)blockIdx.x);
#pragma nounroll
            for (int rep = 0; rep < REP_G1; ++rep) pg8::gemm_phase<Epi, pg8::StaticOrder, false>(lds, g, S, E, nullptr);
        }
        XBAR(xb);
        if (kind == 0) {
#pragma nounroll
            for (int rep = 0; rep < REP_ATTN; ++rep) phase_attn(wv, lp(kp), j, lds); }
        else if (kind == 1) {
#pragma nounroll
            for (int rep = 0; rep < REP_RET; ++rep) phase_ret(wv, lp(kp), lds);
            XBAR(xb);
#pragma nounroll
            for (int rep = 0; rep < REP_EW; ++rep) phase_retfin(wv, lp(kp)); }
        else {
#pragma nounroll
            for (int rep = 0; rep < REP_EW; ++rep) phase_convfin(wv, lp(kp)); }
        XBAR(xb);
        {
            pg8::Gemm g; g.M = 8192; g.N = 1024;
            if (kind == 0) { g.A = (const u16*)(p->ws + WS_ABUF); g.Bt = (const u16*)(p->ws + (j == 0 ? WS_WT_OA0 : WS_WT_OA1)); g.K = 1024; }
            else if (kind == 1) { g.A = (const u16*)(p->ws + UR_QR); g.Bt = (const u16*)(p->ws + WS_WT_OB); g.K = 2048; }
            else { g.A = (const u16*)(p->ws + WS_ABUF); g.Bt = (const u16*)(p->ws + WS_WT_OC); g.K = 1024; }
            g.KL = g.K >> 1;
            Epi E; E.kind = 3; E.layer = li; E.j = j; E.p = lp(kp);
            S.init(g.M, g.N, (int)gridDim.x, (int)blockIdx.x, 2);
#pragma nounroll
            for (int rep = 0; rep < (li == 0 ? REP_G2L0 : 1); ++rep) pg8::gemm_phase<Epi, pg8::StaticOrder, false>(lds, g, S, E, nullptr);
        }
        XBAR(xb);
#pragma nounroll
        for (int rep = 0; rep < REP_LN; ++rep) phase_ln(wv, lp(kp), li, li + 1, true);
        phase_ln(wv, lp(kp), li, li + 1);
        if (li == 2) cache_convert(wv, lp(kp), 1);
        XBAR(xb);
    }
}

extern "C" void kernel_launch(void* const* d_in, const int* in_sizes, int n_in, void* d_out, int out_size, void* d_ws, size_t ws_size, hipStream_t stream) {
    static int grid_blocks = 0;
    if (!grid_blocks) {
        int dev = 0, cus = 0, per_cu = 0;
        hipGetDevice(&dev);
        hipDeviceGetAttribute(&cus, hipDeviceAttributeMultiprocessorCount, dev);
        hipFuncSetAttribute((const void*)mega, hipFuncAttributeMaxDynamicSharedMemorySize, LDS_BYTES);
        hipOccupancyMaxActiveBlocksPerMultiprocessor(&per_cu, mega, NTHREADS, LDS_BYTES);
        if (per_cu < 1) per_cu = 1;
        if (per_cu > 1) per_cu = 1;
        grid_blocks = cus * per_cu;
        if (ws_size < WS_NEEDED) fprintf(stderr, "workspace too small: %zu < %zu\n", ws_size, (size_t)WS_NEEDED);
    }
    Prm p{};
    for (int i = 0; i < 23; ++i) p.in[i] = (const float*)d_in[i];
    p.out = (float*)d_out;
    p.ws = (char*)d_ws;
    p.lam_init[0] = (float)(0.8 - 0.6 * exp(-0.3 * 0.0));
    p.lam_init[1] = (float)(0.8 - 0.6 * exp(-0.3 * 3.0));
    hipMemsetAsync((char*)d_ws + WS_BAR, 0, 16384, stream);
    void* args[] = {&p};
    hipError_t e = hipLaunchCooperativeKernel((void*)mega, dim3(grid_blocks), dim3(NTHREADS), args, LDS_BYTES, stream);
    if (e != hipSuccess) fprintf(stderr, "cooperative launch failed: %s (grid %d)\n", hipGetErrorString(e), grid_blocks);
}
```
